# Optimizing an MI355X kernel written in HIP

```python
import jax, jax.numpy as jnp
from jax import lax
import numpy as np

D_MODEL = 2048
BATCH = 4
SEQ = 8192
DEPTH = 2

N_EVEN = (DEPTH + 1) // 2
N_ODD = DEPTH // 2
HEAD_DIM = 64
EPS = 1e-6
LN_EPS = 1e-5

ATT_HEADS = 16
ATT_KV_HEADS = 4
ATT_GROUP = ATT_HEADS // ATT_KV_HEADS
ATT_Q = ATT_HEADS * HEAD_DIM
ATT_KV = ATT_KV_HEADS * HEAD_DIM
WINDOW = 128
ATT_BLOCK = 128
ROPE_THETA = 10000.0
CONV_CH = 1024
CONV_WIDTH = 31
AB_IN = ATT_Q + 2 * ATT_KV + 2 * CONV_CH
AB_OUT = ATT_Q + CONV_CH

RWKV_HEADS = 16
RWKV_DIM = RWKV_HEADS * HEAD_DIM
DECAY_LORA = 96
AAA_LORA = 96
GATE_LORA = 256
RWKV_LN_EPS = 64e-5
CD_SHIFT = 3 * RWKV_DIM + DECAY_LORA + AAA_LORA + GATE_LORA
LRU_WIDTH = 1024
LRU_BLOCKS = 16
LRU_BLOCK_DIM = LRU_WIDTH // LRU_BLOCKS
LRU_CONV_WIDTH = 4
LRU_C = 8.0
CD_IN = CD_SHIFT + 2 * LRU_WIDTH
CD_OUT = RWKV_DIM + LRU_WIDTH

N_EXPERTS = 16
N_GROUPS = 4
EXPERTS_PER_GROUP = N_EXPERTS // N_GROUPS
TOP_K = 2
D_EXPERT = 1024
MOE_BLOCK = 256

kernel_name = 'hybrid_swa_conformer_rwkv7_rglru_moe'


def rms_norm(x, g):
    xf = x.astype(jnp.float32)
    y = xf * lax.rsqrt(jnp.mean(xf * xf, axis=-1, keepdims=True) + EPS)
    return (y * g.astype(jnp.float32)).astype(x.dtype)


def layer_norm(x, g, b):
    xf = x.astype(jnp.float32)
    mu = jnp.mean(xf, axis=-1, keepdims=True)
    var = jnp.mean(jnp.square(xf - mu), axis=-1, keepdims=True)
    y = (xf - mu) * lax.rsqrt(var + LN_EPS)
    return (y * g.astype(jnp.float32) + b.astype(jnp.float32)).astype(x.dtype)


def modulate(h, shift, scale):
    return h * (1.0 + scale[:, None, :]) + shift[:, None, :]


def rope(x, positions):
    half = HEAD_DIM // 2
    inv_freq = ROPE_THETA ** (-jnp.arange(half, dtype=jnp.float32) / half)
    ang = positions.astype(jnp.float32)[..., None] * inv_freq
    cos = jnp.cos(ang)[:, :, None, :]
    sin = jnp.sin(ang)[:, :, None, :]
    xf = x.astype(jnp.float32)
    x1, x2 = xf[..., :half], xf[..., half:]
    return jnp.concatenate([x1 * cos - x2 * sin, x2 * cos + x1 * sin], axis=-1).astype(x.dtype)


def token_shift(z):
    return jnp.pad(z[:, :-1], ((0, 0), (1, 0), (0, 0)))


def causal_depthwise_conv(x, w, b):
    width = w.shape[0]
    y = lax.conv_general_dilated(x, w.astype(x.dtype), window_strides=(1,), padding=[(width - 1, 0)],
                                 dimension_numbers=('NWC', 'WIO', 'NWC'), feature_group_count=x.shape[-1])
    return y + b


def sliding_window_attention(q, k, v, sinks):
    B, S = q.shape[0], q.shape[1]
    nb = S // ATT_BLOCK
    qb = q.reshape(B, nb, ATT_BLOCK, ATT_KV_HEADS, ATT_GROUP, HEAD_DIM)
    kb = k.reshape(B, nb, ATT_BLOCK, ATT_KV_HEADS, HEAD_DIM)
    vb = v.reshape(B, nb, ATT_BLOCK, ATT_KV_HEADS, HEAD_DIM)

    def with_prev(t):
        prev = jnp.pad(t[:, :-1], ((0, 0), (1, 0), (0, 0), (0, 0), (0, 0)))
        return jnp.concatenate([prev, t], axis=2)

    kk, vv = with_prev(kb), with_prev(vb)
    s = jnp.einsum('bnqhgd,bnkhd->bnhgqk', qb, kk).astype(jnp.float32) * (HEAD_DIM ** -0.5)
    qi = jnp.arange(ATT_BLOCK)[:, None]
    kj = jnp.arange(2 * ATT_BLOCK)[None, :]
    dist = ATT_BLOCK + qi - kj
    kpos = (jnp.arange(nb)[:, None, None] - 1) * ATT_BLOCK + kj[None]
    valid = (dist >= 0) & (dist < WINDOW) & (kpos >= 0)
    s = jnp.where(valid[None, :, None, None], s, -1e30)
    sink = sinks.astype(jnp.float32).reshape(ATT_KV_HEADS, ATT_GROUP)[None, None, :, :, None, None]
    m = jnp.maximum(jnp.max(s, axis=-1, keepdims=True), sink)
    p = jnp.exp(s - m)
    p = p / (jnp.sum(p, axis=-1, keepdims=True) + jnp.exp(sink - m))
    o = jnp.einsum('bnhgqk,bnkhd->bnqhgd', p.astype(v.dtype), vv)
    return o.reshape(B, S, ATT_Q)


def conformer_conv(u, conv_w, conv_b, ln_g, ln_b):
    val, gate = u[..., :CONV_CH], u[..., CONV_CH:]
    y = val * jax.nn.sigmoid(gate)
    y = causal_depthwise_conv(y, conv_w, conv_b)
    return jax.nn.silu(layer_norm(y, ln_g, ln_b))


def mixer_ab(h, positions, w_in, sinks, conv_w, conv_b, ln_g, ln_b, w_out):
    B, S, _ = h.shape
    z = h @ w_in
    q, k, v, u = jnp.split(z, [ATT_Q, ATT_Q + ATT_KV, ATT_Q + 2 * ATT_KV], axis=-1)
    q = rope(q.reshape(B, S, ATT_HEADS, HEAD_DIM), positions)
    k = rope(k.reshape(B, S, ATT_KV_HEADS, HEAD_DIM), positions)
    v = v.reshape(B, S, ATT_KV_HEADS, HEAD_DIM)
    att = sliding_window_attention(q, k, v, sinks)
    conv = conformer_conv(u, conv_w, conv_b, ln_g, ln_b)
    return jnp.concatenate([att, conv], axis=-1) @ w_out


def _rwkv7_step(state, inp):
    r_t, w_t, k_t, v_t, kk_t, b_t = inp
    sa = jnp.einsum('bhvk,bhk->bhv', state, -kk_t)
    state = (state * w_t[:, :, None, :]
             + sa[..., None] * b_t[:, :, None, :]
             + v_t[..., None] * k_t[:, :, None, :])
    return state, jnp.einsum('bhvk,bhk->bhv', state, r_t)


def rwkv7_time_mix(r, k, v, zw, za, zg, w0, w2, a0, a2, g2, k_k, k_a, r_k, ln_g, ln_b):
    B, S, _ = r.shape
    f32 = jnp.float32
    heads = lambda t: t.reshape(B, S, RWKV_HEADS, HEAD_DIM)
    w = -jax.nn.softplus(-(w0 + jnp.tanh(zw) @ w2).astype(f32)) - 0.5
    decay = jnp.exp(-jnp.exp(w))
    a = jax.nn.sigmoid((a0 + za @ a2).astype(f32))
    g = jax.nn.sigmoid(zg) @ g2
    kk = heads((k * k_k).astype(f32))
    kk = kk * lax.rsqrt(jnp.maximum(jnp.sum(kk * kk, axis=-1, keepdims=True), 1e-24))
    k = k.astype(f32) * (1.0 + (a - 1.0) * k_a)
    r_h, k_h, v_h, w_h, a_h = heads(r.astype(f32)), heads(k), heads(v.astype(f32)), heads(decay), heads(a)
    xs = tuple(jnp.moveaxis(t, 1, 0) for t in (r_h, w_h, k_h, v_h, kk, kk * a_h))
    state0 = jnp.zeros((B, RWKV_HEADS, HEAD_DIM, HEAD_DIM), f32)
    _, y = lax.scan(_rwkv7_step, state0, xs)
    y = jnp.moveaxis(y, 0, 1)
    mu = jnp.mean(y, axis=-1, keepdims=True)
    var = jnp.mean(jnp.square(y - mu), axis=-1, keepdims=True)
    y = ((y - mu) * lax.rsqrt(var + RWKV_LN_EPS)).reshape(B, S, RWKV_DIM) * ln_g + ln_b
    bonus = jnp.sum(r_h * k_h * r_k, axis=-1, keepdims=True) * v_h
    y = (y + bonus.reshape(B, S, RWKV_DIM)) * g
    return y.astype(r.dtype)


def _linear_recurrence_combine(left, right):
    a_l, b_l = left
    a_r, b_r = right
    return a_l * a_r, a_r * b_l + b_r


def rglru_branch(zd, conv_w, conv_b, wa, ba, wx, bx, lam):
    B, S, _ = zd.shape
    f32 = jnp.float32
    xb, gb = zd[..., :LRU_WIDTH], zd[..., LRU_WIDTH:]
    xb = causal_depthwise_conv(xb, conv_w, conv_b)
    xh = xb.reshape(B, S, LRU_BLOCKS, LRU_BLOCK_DIM)
    gate_r = jnp.einsum('bsgi,gij->bsgj', xh, wa).reshape(B, S, LRU_WIDTH) + ba
    gate_i = jnp.einsum('bsgi,gij->bsgj', xh, wx).reshape(B, S, LRU_WIDTH) + bx
    r = jax.nn.sigmoid(gate_r.astype(f32))
    i = jax.nn.sigmoid(gate_i.astype(f32))
    log_a = -LRU_C * r * jax.nn.softplus(-lam.astype(f32))
    a = jnp.exp(log_a)
    u = jnp.sqrt(-jnp.expm1(2.0 * log_a)) * (i * xb.astype(f32))
    _, hseq = lax.associative_scan(_linear_recurrence_combine, (a, u), axis=1)
    return (hseq * jax.nn.gelu(gb.astype(f32))).astype(zd.dtype)


def mixer_cd(h, w_in, shift_mu, w0, w2, a0, a2, g2, k_k, k_a, r_k, ln_g, ln_b,
             conv_w, conv_b, wa, ba, wx, bx, lam, w_out):
    z = h @ w_in
    zc, zd = z[..., :CD_SHIFT], z[..., CD_SHIFT:]
    zc = zc + shift_mu * (token_shift(zc) - zc)
    r, k, v, zw, za, zg = jnp.split(zc, [RWKV_DIM, 2 * RWKV_DIM, 3 * RWKV_DIM,
                                         3 * RWKV_DIM + DECAY_LORA,
                                         3 * RWKV_DIM + DECAY_LORA + AAA_LORA], axis=-1)
    y_c = rwkv7_time_mix(r, k, v, zw, za, zg, w0, w2, a0, a2, g2, k_k, k_a, r_k, ln_g, ln_b)
    y_d = rglru_branch(zd, conv_w, conv_b, wa, ba, wx, bx, lam)
    return jnp.concatenate([y_c, y_d], axis=-1) @ w_out


def route(xt, router_w, router_bias):
    probs = jax.nn.softmax((xt @ router_w).astype(jnp.float32), axis=-1)
    sel = (probs + router_bias.astype(jnp.float32)).reshape(-1, N_GROUPS, EXPERTS_PER_GROUP)
    group_score = jnp.sum(lax.top_k(sel, TOP_K)[0], axis=-1)
    g_idx = jnp.argmax(group_score, axis=-1)
    in_group = jnp.take_along_axis(sel, g_idx[:, None, None], axis=1)[:, 0]
    _, local = lax.top_k(in_group, TOP_K)
    expert_idx = (g_idx[:, None] * EXPERTS_PER_GROUP + local).astype(jnp.int32)
    gate = jnp.take_along_axis(probs, expert_idx, axis=1)
    return expert_idx, gate / jnp.sum(gate, axis=-1, keepdims=True)


def moe_ffn(h, router_w, router_bias, w1, w3, w2):
    B, S, D = h.shape
    xt = h.reshape(-1, D)
    n = xt.shape[0]
    nk = n * TOP_K
    expert_idx, gate = route(xt, router_w, router_bias)
    flat_e = expert_idx.reshape(-1)
    flat_tok = jnp.repeat(jnp.arange(n, dtype=jnp.int32), TOP_K)
    flat_w = gate.reshape(-1)
    order = jnp.argsort(flat_e)
    se = flat_e[order]
    counts = jnp.zeros((N_EXPERTS,), jnp.int32).at[flat_e].add(1)
    padded = (counts + MOE_BLOCK - 1) // MOE_BLOCK * MOE_BLOCK
    start = jnp.cumsum(counts) - counts
    pstart = jnp.cumsum(padded) - padded
    pend = pstart + padded
    dest = pstart[se] + (jnp.arange(nk, dtype=jnp.int32) - start[se])
    n_blocks = -(-nk // MOE_BLOCK) + N_EXPERTS
    rows = n_blocks * MOE_BLOCK
    row_tok = jnp.full((rows,), n, jnp.int32).at[dest].set(flat_tok[order])
    row_w = jnp.zeros((rows,), h.dtype).at[dest].set(flat_w[order].astype(h.dtype))
    block_start = jnp.arange(n_blocks, dtype=jnp.int32) * MOE_BLOCK
    block_e = jnp.minimum(jnp.sum(block_start[:, None] >= pend[None, :], axis=1), N_EXPERTS - 1)
    x_pad = jnp.concatenate([xt, jnp.zeros((1, D), xt.dtype)], axis=0)
    xb = x_pad[row_tok].reshape(n_blocks, MOE_BLOCK, D)

    def expert_block(args):
        xblk, e = args
        hid = jax.nn.silu(xblk @ w1[e]) * (xblk @ w3[e])
        return hid @ w2[e]

    yb = lax.map(expert_block, (xb, block_e))
    y = jnp.zeros((n + 1, D), h.dtype).at[row_tok].add(yb.reshape(rows, D) * row_w[:, None])
    return y[:n].reshape(B, S, D)


def setup_inputs(seed: int = 0) -> dict:
    key = jax.random.key(seed)
    ks = iter(jax.random.split(key, 48))
    f32 = jnp.float32

    def nrm(shape, scale):
        return scale * jax.random.normal(next(ks), shape, f32)

    def gain(shape):
        return 1.0 + nrm(shape, 0.02)

    def unif(shape, lo, hi):
        return jax.random.uniform(next(ks), shape, f32, lo, hi)

    D = D_MODEL
    x = nrm((BATCH, SEQ, D), 1.0)
    c = nrm((BATCH, D), 1.0)
    positions = (jax.random.randint(next(ks), (BATCH, 1), 0, 1024, jnp.int32)
                 + jnp.arange(SEQ, dtype=jnp.int32)[None, :])
    router_w = nrm((D, N_EXPERTS), D ** -0.5)
    router_bias = nrm((N_EXPERTS,), 0.01)
    ada_w = nrm((DEPTH, D, 6 * D), 0.5 * D ** -0.5)
    ada_b = nrm((DEPTH, 6 * D), 0.02)
    norm_mix = gain((DEPTH, D))
    norm_ffn = gain((DEPTH, D))
    moe_w1 = nrm((DEPTH, N_EXPERTS, D, D_EXPERT), D ** -0.5)
    moe_w3 = nrm((DEPTH, N_EXPERTS, D, D_EXPERT), D ** -0.5)
    moe_w2 = nrm((DEPTH, N_EXPERTS, D_EXPERT, D), D_EXPERT ** -0.5)
    ab_w_in = nrm((N_EVEN, D, AB_IN), D ** -0.5)
    ab_sinks = nrm((N_EVEN, ATT_HEADS), 0.5)
    ab_conv_w = nrm((N_EVEN, CONV_WIDTH, 1, CONV_CH), CONV_WIDTH ** -0.5)
    ab_conv_b = nrm((N_EVEN, CONV_CH), 0.02)
    ab_conv_ln_g = gain((N_EVEN, CONV_CH))
    ab_conv_ln_b = nrm((N_EVEN, CONV_CH), 0.02)
    ab_w_out = nrm((N_EVEN, AB_OUT, D), AB_OUT ** -0.5)
    cd_w_in = nrm((N_ODD, D, CD_IN), D ** -0.5)
    cd_shift_mu = unif((N_ODD, CD_SHIFT), 0.0, 1.0)
    cd_w0 = unif((N_ODD, RWKV_DIM), -3.0, 1.0)
    cd_w2 = nrm((N_ODD, DECAY_LORA, RWKV_DIM), 0.1 * DECAY_LORA ** -0.5)
    cd_a0 = nrm((N_ODD, RWKV_DIM), 0.5)
    cd_a2 = nrm((N_ODD, AAA_LORA, RWKV_DIM), 0.1 * AAA_LORA ** -0.5)
    cd_g2 = nrm((N_ODD, GATE_LORA, RWKV_DIM), GATE_LORA ** -0.5)
    cd_k_k = 0.85 + nrm((N_ODD, RWKV_DIM), 0.02)
    cd_k_a = gain((N_ODD, RWKV_DIM))
    cd_r_k = nrm((N_ODD, RWKV_HEADS, HEAD_DIM), 0.1)
    cd_ln_x_g = gain((N_ODD, RWKV_DIM))
    cd_ln_x_b = nrm((N_ODD, RWKV_DIM), 0.02)
    cd_lru_conv_w = nrm((N_ODD, LRU_CONV_WIDTH, 1, LRU_WIDTH), 0.5)
    cd_lru_conv_b = nrm((N_ODD, LRU_WIDTH), 0.02)
    cd_lru_wa = nrm((N_ODD, LRU_BLOCKS, LRU_BLOCK_DIM, LRU_BLOCK_DIM), LRU_BLOCK_DIM ** -0.5)
    cd_lru_ba = nrm((N_ODD, LRU_WIDTH), 0.02)
    cd_lru_wx = nrm((N_ODD, LRU_BLOCKS, LRU_BLOCK_DIM, LRU_BLOCK_DIM), LRU_BLOCK_DIM ** -0.5)
    cd_lru_bx = nrm((N_ODD, LRU_WIDTH), 0.02)
    a_c = unif((N_ODD, LRU_WIDTH), 0.9, 0.999)
    sig = a_c ** (1.0 / LRU_C)
    cd_lru_lambda = jnp.log(sig) - jnp.log1p(-sig)
    cd_w_out = nrm((N_ODD, CD_OUT, D), CD_OUT ** -0.5)
    final_norm = gain((D,))
    return {'x': x, 'c': c, 'positions': positions, 'router_w': router_w, 'router_bias': router_bias,
            'ada_w': ada_w, 'ada_b': ada_b, 'norm_mix': norm_mix, 'norm_ffn': norm_ffn,
            'moe_w1': moe_w1, 'moe_w3': moe_w3, 'moe_w2': moe_w2,
            'ab_w_in': ab_w_in, 'ab_sinks': ab_sinks, 'ab_conv_w': ab_conv_w, 'ab_conv_b': ab_conv_b,
            'ab_conv_ln_g': ab_conv_ln_g, 'ab_conv_ln_b': ab_conv_ln_b, 'ab_w_out': ab_w_out,
            'cd_w_in': cd_w_in, 'cd_shift_mu': cd_shift_mu, 'cd_w0': cd_w0, 'cd_w2': cd_w2,
            'cd_a0': cd_a0, 'cd_a2': cd_a2, 'cd_g2': cd_g2, 'cd_k_k': cd_k_k, 'cd_k_a': cd_k_a,
            'cd_r_k': cd_r_k, 'cd_ln_x_g': cd_ln_x_g, 'cd_ln_x_b': cd_ln_x_b,
            'cd_lru_conv_w': cd_lru_conv_w, 'cd_lru_conv_b': cd_lru_conv_b,
            'cd_lru_wa': cd_lru_wa, 'cd_lru_ba': cd_lru_ba, 'cd_lru_wx': cd_lru_wx, 'cd_lru_bx': cd_lru_bx,
            'cd_lru_lambda': cd_lru_lambda, 'cd_w_out': cd_w_out, 'final_norm': final_norm}


def reference(x, c, positions, router_w, router_bias, ada_w, ada_b, norm_mix, norm_ffn,
              moe_w1, moe_w3, moe_w2, ab_w_in, ab_sinks, ab_conv_w, ab_conv_b, ab_conv_ln_g,
              ab_conv_ln_b, ab_w_out, cd_w_in, cd_shift_mu, cd_w0, cd_w2, cd_a0, cd_a2, cd_g2,
              cd_k_k, cd_k_a, cd_r_k, cd_ln_x_g, cd_ln_x_b, cd_lru_conv_w, cd_lru_conv_b,
              cd_lru_wa, cd_lru_ba, cd_lru_wx, cd_lru_bx, cd_lru_lambda, cd_w_out, final_norm):
    c_act = jax.nn.silu(c)
    for layer in range(DEPTH):
        j = layer // 2
        mod = c_act @ ada_w[layer] + ada_b[layer]
        shift_m, scale_m, gate_m, shift_f, scale_f, gate_f = jnp.split(mod, 6, axis=-1)
        h = modulate(rms_norm(x, norm_mix[layer]), shift_m, scale_m)
        if layer % 2 == 0:
            y = mixer_ab(h, positions, ab_w_in[j], ab_sinks[j], ab_conv_w[j], ab_conv_b[j],
                         ab_conv_ln_g[j], ab_conv_ln_b[j], ab_w_out[j])
        else:
            y = mixer_cd(h, cd_w_in[j], cd_shift_mu[j], cd_w0[j], cd_w2[j], cd_a0[j], cd_a2[j],
                         cd_g2[j], cd_k_k[j], cd_k_a[j], cd_r_k[j], cd_ln_x_g[j], cd_ln_x_b[j],
                         cd_lru_conv_w[j], cd_lru_conv_b[j], cd_lru_wa[j], cd_lru_ba[j],
                         cd_lru_wx[j], cd_lru_bx[j], cd_lru_lambda[j], cd_w_out[j])
        x = x + gate_m[:, None, :] * y
        h = modulate(rms_norm(x, norm_ffn[layer]), shift_f, scale_f)
        x = x + gate_f[:, None, :] * moe_ffn(h, router_w, router_bias, moe_w1[layer], moe_w3[layer], moe_w2[layer])
    return rms_norm(x, final_norm)
```

```cpp
#include <hip/hip_runtime.h>
#include <stdint.h>
#include <stdio.h>

#define LAS __attribute__((address_space(3)))
typedef unsigned short bf16_t;
typedef short bf16x8 __attribute__((ext_vector_type(8)));
typedef float f32x2 __attribute__((ext_vector_type(2)));
typedef float f32x4 __attribute__((ext_vector_type(4)));
typedef float f32x16 __attribute__((ext_vector_type(16)));
typedef unsigned u32x2 __attribute__((ext_vector_type(2)));
typedef unsigned u32x4 __attribute__((ext_vector_type(4)));

constexpr int DM = 2048, NB = 4, SEQ = 8192, NTOK = NB * SEQ;
constexpr int PREP_PT = 4;
constexpr int AB_IN = 3584, CD_IN = 5568, ZLD1 = 5632;
constexpr int NEXP = 16, DEXP = 1024;
constexpr int MOE_ROWS = NTOK * 2 + NEXP * 256;
constexpr float LOG2E = 1.4426950408889634f;

constexpr size_t MiB = (size_t)1 << 20;
constexpr size_t WS_CTL = 0, CTL_ZERO_BYTES = 2 * MiB;
constexpr size_t CTL_CNT = 57344;
constexpr size_t CTL_CUR = 57344 + 256;
constexpr size_t CTL_MOD = 65536;
constexpr size_t WS_BWA = 2 * MiB, WS_BG = 3 * MiB, WS_BLRU = 3 * MiB + 512 * 1024;
constexpr size_t WS_ROWTOK = 4 * MiB + 512 * 1024;
constexpr size_t WS_ROPE = 5 * MiB;
constexpr size_t WS_TOKE = 13 * MiB, WS_TOKG = WS_TOKE + 256 * 1024, WS_TOKP = WS_TOKG + 256 * 1024;
constexpr size_t WS_SUMA = 14 * MiB, WS_SUMH = 15 * MiB;
constexpr size_t WS_WIN0 = 16 * MiB, WS_WIN1 = 30 * MiB, WS_WOUT0 = 52 * MiB, WS_WOUT1 = 60 * MiB;
constexpr size_t WS_MW13 = 68 * MiB, WS_MW2 = 196 * MiB;
constexpr size_t WS_H = 260 * MiB;
constexpr size_t WS_KK = WS_H, WS_BB = WS_H + 64 * MiB, WS_CAT1 = WS_H;
constexpr size_t WS_Z = 388 * MiB;
constexpr size_t WS_YB = WS_Z;
constexpr size_t WS_X3 = WS_Z + 160 * MiB;
constexpr size_t WS_R = 740 * MiB;
constexpr size_t WS_CAT0 = WS_R, WS_HID = WS_R, WS_RKV = WS_R;
constexpr size_t WS_S = 932 * MiB;
constexpr size_t WS_LIN = WS_S, WS_Y = WS_S, WS_LD = WS_S + 96 * MiB, WS_G = WS_LD + 64 * MiB, WS_LOGA = WS_G + 64 * MiB, WS_U = WS_LOGA + 64 * MiB;
constexpr size_t WS_XS = WS_S;
constexpr size_t WS_CONVTMP = WS_S;
constexpr size_t WS_END = WS_U + 64 * MiB;
static_assert(WS_XS + (size_t)MOE_ROWS * 2048 * 2 <= WS_END, "XS fits");
static_assert(WS_HID + (size_t)MOE_ROWS * 1024 * 2 <= WS_S, "HID fits");
static_assert(WS_YB + (size_t)MOE_ROWS * 2048 * 2 <= WS_R, "YB fits");

constexpr int LDS_MISC = 4096;
constexpr int LDS_STAGE = 4096;
constexpr int LDS_BYTES = 4096 + 5 * 24576 + 2 * 16640;
constexpr int MISC_XB = 0;
constexpr int MISC_HIST = 64;
constexpr int MISC_TSTART = 128;
constexpr int MISC_BBASE = 256;
constexpr int MISC_SCAN = 320;

__device__ __forceinline__ float bflo(unsigned w) { return __uint_as_float(w << 16); }
__device__ __forceinline__ float bfhi(unsigned w) { return __uint_as_float(w & 0xffff0000u); }
__device__ __forceinline__ unsigned pk2(float lo, float hi) { unsigned r; asm volatile("v_cvt_pk_bf16_f32 %0, %1, %2" : "=v"(r) : "v"(lo), "v"(hi)); return r; }
__device__ __forceinline__ float wave_sum(float v) {
#pragma unroll
    for (int o = 32; o >= 1; o >>= 1) v += __shfl_xor(v, o);
    return v;
}
__device__ __forceinline__ float fast_exp(float x) { return __builtin_amdgcn_exp2f(x * LOG2E); }
__device__ __forceinline__ float fast_rcp(float x) { return __builtin_amdgcn_rcpf(x); }
__device__ __forceinline__ float sigmoidf_(float x) { return fast_rcp(1.0f + fast_exp(-x)); }
__device__ __forceinline__ float siluf_(float x) { return x * sigmoidf_(x); }
__device__ __forceinline__ float tanhf_(float x) { const float e = fast_exp(2.0f * x); return 1.0f - 2.0f * fast_rcp(e + 1.0f); }
__device__ __forceinline__ float softplusf_(float x) { return fmaxf(x, 0.0f) + __builtin_amdgcn_logf(1.0f + fast_exp(-fabsf(x))) * 0.6931471805599453f; }
__device__ __forceinline__ float gelu_tanh(float x) { const float u = 0.7978845608028654f * (x + 0.044715f * x * x * x); return 0.5f * x * (1.0f + tanhf_(u)); }
__device__ __forceinline__ float fma_s(float a, float b, float c) { float d; asm("v_fma_f32 %0, %1, %2, %3" : "=v"(d) : "v"(a), "v"(b), "v"(c)); return d; }
__device__ __forceinline__ float mul_s(float a, float b) { float d; asm("v_mul_f32 %0, %1, %2" : "=v"(d) : "v"(a), "v"(b)); return d; }
__device__ __forceinline__ int lane_now() { int t = threadIdx.x; asm volatile("" : "+v"(t)); return t & 63; }
__device__ __forceinline__ void lds_wait() { asm volatile("s_waitcnt lgkmcnt(0)" ::: "memory"); }
__device__ __forceinline__ void unpack8(const u32x4 w, float (&f)[8]) {
    f[0] = bflo(w.x); f[1] = bfhi(w.x); f[2] = bflo(w.y); f[3] = bfhi(w.y); f[4] = bflo(w.z); f[5] = bfhi(w.z); f[6] = bflo(w.w); f[7] = bfhi(w.w);
}
__device__ __forceinline__ u32x4 pack8(const float (&f)[8]) { u32x4 w; w.x = pk2(f[0], f[1]); w.y = pk2(f[2], f[3]); w.z = pk2(f[4], f[5]); w.w = pk2(f[6], f[7]); return w; }

#define XB_TMO      128
#define XB_XCNT(j)  (256  + 64 * (j))
#define XB_XSUB(j)  (1280 + 64 * (j))
#define XB_XGEN(j)  (2304 + 64 * (j))
#define XB_TOP      3328
#define XB_TOPGEN   3392
#define XCD_BAR_WORDS 3456
#define XB_SPIN_CAP (1u << 18)

__device__ __forceinline__ unsigned xb_ld(unsigned* p)              { return __hip_atomic_load(p, __ATOMIC_RELAXED, __HIP_MEMORY_SCOPE_AGENT); }
__device__ __forceinline__ unsigned xb_add(unsigned* p, unsigned v) { return __hip_atomic_fetch_add(p, v, __ATOMIC_RELAXED, __HIP_MEMORY_SCOPE_AGENT); }
__device__ __forceinline__ unsigned xb_xcc_id() { return (unsigned)__builtin_amdgcn_s_getreg((3 << 11) | 20) & 0xFu; }
#define XB_SPIN(cond, bar) do { unsigned _sp = 0; while (cond) { __builtin_amdgcn_s_sleep(1); \
    if ((++_sp & 255u) == 0u) { if (xb_ld(&(bar)[XB_TMO])) break; if (_sp > XB_SPIN_CAP) { atomicAdd(&(bar)[XB_TMO], 1u); break; } } } } while (0)

struct XcdBarrier {
    unsigned* bar; unsigned x;
    volatile LAS unsigned* st;
};
__device__ __forceinline__ XcdBarrier xcd_barrier_post(unsigned* bar, volatile LAS unsigned* st) {
    XcdBarrier b; b.bar = bar; b.x = xb_xcc_id(); b.st = st;
    if (threadIdx.x == 0) (void)xb_add(&bar[XB_XCNT(b.x)], 1u);
    return b;
}
__device__ __forceinline__ void xcd_barrier_complete(unsigned* bar, unsigned x, unsigned& nloc, unsigned& nx) {
    const unsigned G = gridDim.x * gridDim.y * gridDim.z;
    unsigned sum, cnt, mine, sp = 0u;
    for (;;) {
        sum = 0u; cnt = 0u; mine = 0u;
#pragma unroll
        for (unsigned j = 0; j < 16; ++j) { const unsigned c = xb_ld(&bar[XB_XCNT(j)]); sum += c; cnt += (c > 0u) ? 1u : 0u; mine = (j == x) ? c : mine; }
        if (sum == G) break;
        __builtin_amdgcn_s_sleep(1);
        if ((++sp & 255u) == 0u) { if (xb_ld(&bar[XB_TMO])) break; if (sp > XB_SPIN_CAP) { atomicAdd(&bar[XB_TMO], 1u); break; } }
    }
    nloc = mine > 0u ? mine : 1u; nx = cnt > 0u ? cnt : 1u;
}
__device__ __forceinline__ void xcd_barrier(const XcdBarrier& b) {
    asm volatile("s_waitcnt vmcnt(0)" ::: "memory");
    __syncthreads();
    if (threadIdx.x == 0) {
        unsigned* bar = b.bar;
        __builtin_amdgcn_s_waitcnt(0);
        unsigned nloc = b.st[0], nx = b.st[1];
        if (nloc == 0u) { xcd_barrier_complete(bar, b.x, nloc, nx); b.st[0] = nloc; b.st[1] = nx; }
        const unsigned old = xb_add(&bar[XB_XSUB(b.x)], 1u);
        const unsigned gen = old / nloc;
        if (old + 1u == (gen + 1u) * nloc) {
            __builtin_amdgcn_fence(__ATOMIC_RELEASE, "agent");
            asm volatile("s_waitcnt vmcnt(0)" ::: "memory");
            const unsigned og = xb_add(&bar[XB_TOP], 1u);
            const unsigned tg = og / nx;
            if (og + 1u == (tg + 1u) * nx) xb_add(&bar[XB_TOPGEN], 1u);
            else XB_SPIN(xb_ld(&bar[XB_TOPGEN]) == tg, bar);
            __builtin_amdgcn_fence(__ATOMIC_ACQUIRE, "agent");
            xb_add(&bar[XB_XGEN(b.x)], 1u);
            asm volatile("s_waitcnt vmcnt(0)" ::: "memory");
        } else {
            XB_SPIN(xb_ld(&bar[XB_XGEN(b.x)]) == gen, bar);
            __builtin_amdgcn_fence(__ATOMIC_ACQUIRE, "agent");
            asm volatile("s_waitcnt vmcnt(0)" ::: "memory");
        }
    }
    __syncthreads();
}

namespace g8 {
constexpr int BM = 256, BK = 64, HALF = 128, HTB = HALF * BK * 2, STAGE_BYTES = 8 * HTB, NXCD = 8, WGM = 8;
__device__ __forceinline__ int lds_byte(int r, int c) { const int st = (r >> 4) * 2 + (c >> 5), rr = r & 15, cc = c & 31, ob = rr * 64 + cc * 2; return st * 1024 + (ob ^ (((ob >> 9) & 1) << 5)); }
__device__ __forceinline__ void stage_rc(int b, int& R, int& C) { const int st = b / 1024, sb = b % 1024, swz = sb ^ (((sb >> 9) & 1) << 5); R = (st >> 1) * 16 + swz / 64; C = (st & 1) * 32 + (swz % 64) / 2; }
__device__ __forceinline__ int perm32(int rho) { const int n = rho >> 4, i = rho & 15; return 8 * (i >> 2) + 4 * n + (i & 3); }

struct Unit { int pm, pn, kind, e; };
typedef int v8i __attribute__((ext_vector_type(8)));
typedef int v4i __attribute__((ext_vector_type(4)));
__device__ __forceinline__ v8i cat8(const bf16x8 lo, const bf16x8 hi) { const v4i a = __builtin_bit_cast(v4i, lo), b = __builtin_bit_cast(v4i, hi); return __builtin_shufflevector(a, b, 0, 1, 2, 3, 4, 5, 6, 7); }
__device__ __forceinline__ bool tile_of(long L, int nM, int nN, int& pm, int& pn) {
    const int nwg = nM * nN; if (L >= nwg) return false;
    int wgid = (int)L; { const int q = nwg / NXCD, r = nwg % NXCD, xcd = wgid % NXCD, off = wgid / NXCD; wgid = (xcd < r ? xcd * (q + 1) : r * (q + 1) + (xcd - r) * q) + off; }
    const int nig = WGM * nN, gid = wgid / nig, fm = gid * WGM, gsz = (nM - fm) < WGM ? (nM - fm) : WGM;
    pm = fm + ((wgid % nig) % gsz); pn = (wgid % nig) / gsz; return true;
}
struct DenseSched {
    static constexpr bool GATHER = false;
    int nM, nN, G, c; const char* A; const char* B; size_t tA, tB;
    __device__ __forceinline__ bool next(int i, Unit& u) const { u.kind = 0; u.e = 0; return tile_of((long)i * G + c, nM, nN, u.pm, u.pn); }
    __device__ __forceinline__ const char* abase(const Unit& u) const { return A + (size_t)u.pm * tA; }
    __device__ __forceinline__ const char* bbase(const Unit& u) const { return B + (size_t)u.pn * tB; }
};

template <class Epi, class Sched>
__device__ __forceinline__ void gemm_phase(LAS unsigned char* lds, const int lda, const int ldb, const int K, const Sched& S, const Epi& E) {
    const int tid = threadIdx.x, wid = __builtin_amdgcn_readfirstlane(tid >> 6), lane = tid & 63, wr = wid >> 2, wc = wid & 3, fr = lane & 15, fq = lane >> 4;
    const int nt = K / BK;
    unsigned voffA[2], voffB[2];
#pragma unroll
    for (int i = 0; i < 2; ++i) { int R, C; stage_rc(tid * 16 + i * 8192, R, C); const int Rb = Epi::PERM ? ((R & ~31) + perm32(R & 31)) : R;
        voffA[i] = (unsigned)(R * lda + C) * 2u; voffB[i] = (unsigned)(Rb * ldb + C) * 2u; }
    const size_t kstep = (size_t)(BK * 2);
    const size_t hstepA = (size_t)HALF * lda * 2, hstepB = (size_t)HALF * ldb * 2;
    const unsigned ldsw = (unsigned)wid * 1024u;
    const unsigned ldsaddr = (unsigned)(unsigned long)lds + ldsw;
    const int aoff = lds_byte(wr * 64 + fr, fq * 8), boff = lds_byte(wc * 32 + fr, fq * 8);
#define PG8_SA(b, h) (((b) * 2 + (h)) * HTB)
#define PG8_SB(b, h) ((4 + (b) * 2 + (h)) * HTB)
#define PG8_STAGE(bufoff, gbase, voff) do { _Pragma("unroll") for (int _i = 0; _i < 2; ++_i) { unsigned _keep; \
        asm volatile("s_mov_b32 %0, m0\n\ts_mov_b32 m0, %3\n\ts_nop 0\n\tglobal_load_lds_dwordx4 %1, %2\n\ts_mov_b32 m0, %0" : "=&s"(_keep) : "v"((voff)[_i]), "s"((const char*)(gbase)), "s"(ldsaddr + (unsigned)((bufoff) + _i * 8192)) : "memory"); } } while (0)
#define PG8_STAGE_A(bufoff, h, kb, U) do { if constexpr (Sched::GATHER) { const unsigned _vo[2] = {(U) ? vN[h][0] : vC[h][0], (U) ? vN[h][1] : vC[h][1]}; PG8_STAGE(bufoff, gA + (kb), _vo); } \
        else PG8_STAGE(bufoff, ((U) ? nA : cA) + (kb) + (size_t)(h) * hstepA, voffA); } while (0)
#define PG8_LDA(dst, b, h) do { _Pragma("unroll") for (int m = 0; m < 4; ++m) _Pragma("unroll") for (int k = 0; k < 2; ++k) dst[m][k] = *(const LAS bf16x8*)(lds + PG8_SA(b, h) + aoff + m * 2048 + k * 1024); } while (0)
#define PG8_LDB(dst, b, h) do { _Pragma("unroll") for (int n = 0; n < 2; ++n) _Pragma("unroll") for (int k = 0; k < 2; ++k) dst[n][k] = *(const LAS bf16x8*)(lds + PG8_SB(b, h) + boff + n * 2048 + k * 1024); } while (0)
#define PG8_MMA(ai, bj, At, Bt) do { __builtin_amdgcn_s_setprio(1); _Pragma("unroll") for (int m = 0; m < 4; ++m) _Pragma("unroll") for (int n = 0; n < 2; ++n) _Pragma("unroll") for (int k = 0; k < 2; ++k) \
        acc[ai][bj][m][n] = __builtin_amdgcn_mfma_f32_16x16x32_bf16(Bt[n][k], At[m][k], acc[ai][bj][m][n], 0, 0, 0); __builtin_amdgcn_s_setprio(0); } while (0)
#define PG8_LDA8(dst, b, h) do { _Pragma("unroll") for (int m = 0; m < 4; ++m) dst[m] = cat8(*(const LAS bf16x8*)(lds + PG8_SA(b, h) + aoff + m * 2048), *(const LAS bf16x8*)(lds + PG8_SA(b, h) + aoff + m * 2048 + 1024)); } while (0)
#define PG8_LDB8(dst, b, h) do { _Pragma("unroll") for (int n = 0; n < 2; ++n) dst[n] = cat8(*(const LAS bf16x8*)(lds + PG8_SB(b, h) + boff + n * 2048), *(const LAS bf16x8*)(lds + PG8_SB(b, h) + boff + n * 2048 + 1024)); } while (0)
#define PG8_MMA8(ai, bj, At, Bt) do { __builtin_amdgcn_s_setprio(1); _Pragma("unroll") for (int m = 0; m < 4; ++m) _Pragma("unroll") for (int n = 0; n < 2; ++n) \
        asm volatile("v_mfma_scale_f32_16x16x128_f8f6f4 %0, %1, %2, %0, %3, %4 op_sel_hi:[0,0,0]" : "+v"(acc[ai][bj][m][n]) : "v"(Bt[n]), "v"(At[m]), "v"(scB), "v"(scA)); __builtin_amdgcn_s_setprio(0); } while (0)
#define PG8_WAIT_V(n) asm volatile("s_waitcnt vmcnt(" #n ")" ::: "memory")
#define PG8_WAIT_L(n) asm volatile("s_waitcnt lgkmcnt(" #n ")" ::: "memory")
#define PG8_BAR __builtin_amdgcn_s_barrier()
#define PG8_SCHED __builtin_amdgcn_sched_barrier(0)
    Unit cur, nxt; int ui = 0;
    if (!S.next(0, cur)) return;
    f32x4 acc[2][2][4][2];
#pragma unroll
    for (int a = 0; a < 2; ++a)
#pragma unroll
        for (int b = 0; b < 2; ++b)
#pragma unroll
            for (int m = 0; m < 4; ++m)
#pragma unroll
                for (int n = 0; n < 2; ++n) acc[a][b][m][n] = (f32x4){0.f, 0.f, 0.f, 0.f};
    bf16x8 At[4][2], B0[2][2], B1[2][2]; v8i At8[4], B08[2], B18[2]; const int scA = Epi::SC_A, scB = Epi::SC_B;
    const char* cA = S.abase(cur); const char* cB = S.bbase(cur); const char* nA = cA;
    unsigned vC[2][2] = {{0u, 0u}, {0u, 0u}}, vN[2][2] = {{0u, 0u}, {0u, 0u}}; int rawN[2][2] = {{0, 0}, {0, 0}}; const char* gA = cA; int rrow[2] = {0, 0}; unsigned ccol[2] = {0u, 0u};
    if constexpr (Sched::GATHER) { gA = S.gbase();
#pragma unroll
        for (int i = 0; i < 2; ++i) { int R, C; stage_rc(tid * 16 + i * 8192, R, C); rrow[i] = R; ccol[i] = (unsigned)C * 2u; }
#pragma unroll
        for (int h = 0; h < 2; ++h)
#pragma unroll
            for (int i = 0; i < 2; ++i) asm volatile("global_load_dword %0, %1, off" : "=&v"(rawN[h][i]) : "v"(S.rowtab + cur.pm * 256 + h * 128 + rrow[i]) : "memory");
        asm volatile("s_waitcnt vmcnt(0)" : "+v"(rawN[0][0]), "+v"(rawN[0][1]), "+v"(rawN[1][0]), "+v"(rawN[1][1]) :: "memory");
#pragma unroll
        for (int h = 0; h < 2; ++h)
#pragma unroll
            for (int i = 0; i < 2; ++i) { vC[h][i] = (unsigned)rawN[h][i] * (unsigned)(lda * 2) + ccol[i]; vN[h][i] = vC[h][i]; } }
    PG8_STAGE(PG8_SB(0, 0), cB, voffB); PG8_STAGE(PG8_SB(0, 1), cB + hstepB, voffB); PG8_STAGE_A(PG8_SA(0, 0), 0, 0, false); PG8_STAGE_A(PG8_SA(0, 1), 1, 0, false);
    if (wr == 1) PG8_BAR;
    PG8_WAIT_V(2); PG8_BAR;
    PG8_STAGE(PG8_SB(1, 0), cB + kstep, voffB); PG8_STAGE_A(PG8_SA(1, 0), 0, kstep, false); PG8_STAGE(PG8_SB(1, 1), cB + hstepB + kstep, voffB);
    PG8_WAIT_V(6); PG8_BAR;
    for (;;) {
        const bool has_next = S.next(ui + 1, nxt);
        nA = has_next ? S.abase(nxt) : cA; const char* nB = has_next ? S.bbase(nxt) : cB;
#pragma unroll 1
        for (int t = 0; t < nt; t += 2) {
            const bool last = (t == nt - 2);
            const size_t ka1 = (size_t)(t + 1) * kstep, ka2 = last ? (size_t)0 : (size_t)(t + 2) * kstep, ka3 = ka2 + kstep;
            const char* b2 = last ? nB : cB + (size_t)(t + 2) * kstep; const char* b3 = b2 + kstep;
            if constexpr (Sched::GATHER) {
                if (t == 0 && has_next) {
#pragma unroll
                    for (int h = 0; h < 2; ++h)
#pragma unroll
                        for (int i = 0; i < 2; ++i) asm volatile("global_load_dword %0, %1, off" : "=&v"(rawN[h][i]) : "v"(S.rowtab + nxt.pm * 256 + h * 128 + rrow[i]) : "memory"); }
                if (last && has_next) { if (nt < 6) asm volatile("s_waitcnt vmcnt(0)" ::: "memory");
                    asm volatile("" : "+v"(rawN[0][0]), "+v"(rawN[0][1]), "+v"(rawN[1][0]), "+v"(rawN[1][1]));
#pragma unroll
                    for (int h = 0; h < 2; ++h)
#pragma unroll
                        for (int i = 0; i < 2; ++i) vN[h][i] = (unsigned)rawN[h][i] * (unsigned)(lda * 2) + ccol[i]; }
            }
            if constexpr (Epi::F8) {
            PG8_LDB8(B08, 0, 0); PG8_LDB8(B18, 0, 1); PG8_SCHED; PG8_LDA8(At8, 0, 0); PG8_STAGE_A(PG8_SA(1, 1), 1, ka1, false);
            PG8_WAIT_V(8); PG8_WAIT_L(0); PG8_BAR; PG8_MMA8(0, 0, At8, B08); PG8_MMA8(0, 1, At8, B18); PG8_BAR; PG8_SCHED;
            PG8_LDA8(At8, 0, 1); PG8_STAGE(PG8_SB(0, 0), b2, voffB); PG8_STAGE(PG8_SB(0, 1), b2 + hstepB, voffB); PG8_STAGE_A(PG8_SA(0, 0), 0, ka2, last);
            PG8_WAIT_V(8); PG8_WAIT_L(0); PG8_BAR; PG8_MMA8(1, 0, At8, B08); PG8_MMA8(1, 1, At8, B18); PG8_BAR; PG8_SCHED;
            PG8_LDB8(B08, 1, 0); PG8_LDB8(B18, 1, 1); PG8_SCHED; PG8_LDA8(At8, 1, 0); PG8_STAGE_A(PG8_SA(0, 1), 1, ka2, last);
            PG8_WAIT_V(8); PG8_WAIT_L(0); PG8_BAR; PG8_MMA8(0, 0, At8, B08); PG8_MMA8(0, 1, At8, B18); PG8_BAR; PG8_SCHED;
            PG8_LDA8(At8, 1, 1); PG8_STAGE(PG8_SB(1, 0), b3, voffB); PG8_STAGE(PG8_SB(1, 1), b3 + hstepB, voffB); PG8_STAGE_A(PG8_SA(1, 0), 0, ka3, last);
            PG8_WAIT_V(8); PG8_WAIT_L(0); PG8_BAR; PG8_MMA8(1, 0, At8, B08); PG8_MMA8(1, 1, At8, B18); PG8_BAR; PG8_SCHED;
            } else {
            PG8_LDB(B0, 0, 0); PG8_LDB(B1, 0, 1); PG8_SCHED; PG8_LDA(At, 0, 0); PG8_STAGE_A(PG8_SA(1, 1), 1, ka1, false);
            PG8_WAIT_V(8); PG8_WAIT_L(0); PG8_BAR; PG8_MMA(0, 0, At, B0); PG8_MMA(0, 1, At, B1); PG8_BAR; PG8_SCHED;
            PG8_LDA(At, 0, 1); PG8_STAGE(PG8_SB(0, 0), b2, voffB); PG8_STAGE(PG8_SB(0, 1), b2 + hstepB, voffB); PG8_STAGE_A(PG8_SA(0, 0), 0, ka2, last);
            PG8_WAIT_V(8); PG8_WAIT_L(0); PG8_BAR; PG8_MMA(1, 0, At, B0); PG8_MMA(1, 1, At, B1); PG8_BAR; PG8_SCHED;
            PG8_LDB(B0, 1, 0); PG8_LDB(B1, 1, 1); PG8_SCHED; PG8_LDA(At, 1, 0); PG8_STAGE_A(PG8_SA(0, 1), 1, ka2, last);
            PG8_WAIT_V(8); PG8_WAIT_L(0); PG8_BAR; PG8_MMA(0, 0, At, B0); PG8_MMA(0, 1, At, B1); PG8_BAR; PG8_SCHED;
            PG8_LDA(At, 1, 1); PG8_STAGE(PG8_SB(1, 0), b3, voffB); PG8_STAGE(PG8_SB(1, 1), b3 + hstepB, voffB); PG8_STAGE_A(PG8_SA(1, 0), 0, ka3, last);
            PG8_WAIT_V(8); PG8_WAIT_L(0); PG8_BAR; PG8_MMA(1, 0, At, B0); PG8_MMA(1, 1, At, B1); PG8_BAR; PG8_SCHED;
            }
        }
        if (wr == 0) PG8_BAR;
        if constexpr (Epi::F8) {
            asm volatile("s_nop 15\n\ts_nop 15\n\ts_nop 15" : "+v"(acc[1][1][0][0]), "+v"(acc[1][1][0][1]), "+v"(acc[1][1][1][0]), "+v"(acc[1][1][1][1]), "+v"(acc[1][1][2][0]), "+v"(acc[1][1][2][1]), "+v"(acc[1][1][3][0]), "+v"(acc[1][1][3][1]) :: "memory");
            asm volatile("" : "+v"(acc[1][0][0][0]), "+v"(acc[1][0][0][1]), "+v"(acc[1][0][1][0]), "+v"(acc[1][0][1][1]), "+v"(acc[1][0][2][0]), "+v"(acc[1][0][2][1]), "+v"(acc[1][0][3][0]), "+v"(acc[1][0][3][1])); }
        E(acc, cur, wr, wc, fr, fq);
        if (!has_next) break;
#pragma unroll
        for (int a = 0; a < 2; ++a)
#pragma unroll
            for (int b = 0; b < 2; ++b)
#pragma unroll
                for (int m = 0; m < 4; ++m)
#pragma unroll
                    for (int n = 0; n < 2; ++n) acc[a][b][m][n] = (f32x4){0.f, 0.f, 0.f, 0.f};
        cur = nxt; cA = nA; cB = nB; ++ui;
        if constexpr (Sched::GATHER) {
#pragma unroll
            for (int h = 0; h < 2; ++h)
#pragma unroll
                for (int i = 0; i < 2; ++i) vC[h][i] = vN[h][i]; }
        if (wr == 1) PG8_BAR;
    }
    PG8_WAIT_V(0);
    PG8_BAR;
#undef PG8_SA
#undef PG8_SB
#undef PG8_STAGE
#undef PG8_STAGE_A
#undef PG8_LDA
#undef PG8_LDB
#undef PG8_MMA
#undef PG8_MMA8
#undef PG8_LDA8
#undef PG8_LDB8
#undef PG8_WAIT_V
#undef PG8_WAIT_L
#undef PG8_BAR
#undef PG8_SCHED
}
}
struct Args { const void* in[40]; float* out; unsigned char* ws; int ph_lo, ph_hi, li, pad; };
enum { I_X = 0, I_C, I_POS, I_RW, I_RB, I_ADAW, I_ADAB, I_NMIX, I_NFFN, I_W1, I_W3, I_W2, I_ABWIN, I_SINKS, I_CONVW, I_CONVB, I_CLNG, I_CLNB, I_ABWOUT,
       I_CDWIN, I_MU, I_W0, I_LW2, I_A0, I_LA2, I_LG2, I_KK, I_KA, I_RK, I_LNXG, I_LNXB, I_LCW, I_LCB, I_LWA, I_LBA, I_LWX, I_LBX, I_LAM, I_CDWOUT, I_FNORM };
template <int K> __device__ __forceinline__ const float* kin() { const float* p; asm volatile("s_load_dwordx2 %0, %1, %2\n\ts_waitcnt lgkmcnt(0)" : "=s"(p) : "s"(__builtin_amdgcn_kernarg_segment_ptr()), "n"(K * 8) : "memory"); return p; }
#define FIN(k) (kin<k>())
#define WSP(T, off) ((T*)(a.ws + (off)))

__device__ __forceinline__ float clamp448(float v) { return __builtin_amdgcn_fmed3f(v, -448.0f, 448.0f); }
__device__ __forceinline__ unsigned pk4_fp8(float a, float b, float c, float d) { int w = 0; w = __builtin_amdgcn_cvt_pk_fp8_f32(clamp448(a), clamp448(b), w, false); w = __builtin_amdgcn_cvt_pk_fp8_f32(clamp448(c), clamp448(d), w, true); return (unsigned)w; }
__device__ __forceinline__ void transpose_tile(const float* src, int Nsrc, int k0, int n0, bf16_t* dst, int ldk, int drow0, LAS float* scr, int lane) {
#pragma unroll
    for (int i = 0; i < 16; ++i) { const int k = i * 4 + (lane >> 4), n4 = (lane & 15) * 4;
        const f32x4 v = *(const f32x4*)(src + (size_t)(k0 + k) * Nsrc + n0 + n4);
        LAS float* p = scr + k * 65 + n4; p[0] = v.x; p[1] = v.y; p[2] = v.z; p[3] = v.w; }
    lds_wait();
#pragma unroll
    for (int i = 0; i < 8; ++i) { const int n = i * 8 + (lane >> 3), k8 = (lane & 7) * 8; const LAS float* p = scr + k8 * 65 + n;
        u32x4 o; o.x = pk2(p[0], p[65]); o.y = pk2(p[2 * 65], p[3 * 65]); o.z = pk2(p[4 * 65], p[5 * 65]); o.w = pk2(p[6 * 65], p[7 * 65]);
        *(u32x4*)(dst + (size_t)(drow0 + n) * ldk + k0 + k8) = o; }
    lds_wait();
}
__device__ __forceinline__ void transpose_tile8(const float* src, int Nsrc, int k0, int n0, unsigned char* dst, int ldk, int drow0, float sc, LAS float* scr, int lane) {
#pragma unroll
    for (int i = 0; i < 16; ++i) { const int k = i * 4 + (lane >> 4), n4 = (lane & 15) * 4;
        const f32x4 v = *(const f32x4*)(src + (size_t)(k0 + k) * Nsrc + n0 + n4);
        LAS float* p = scr + k * 65 + n4; p[0] = v.x; p[1] = v.y; p[2] = v.z; p[3] = v.w; }
    lds_wait();
#pragma unroll
    for (int i = 0; i < 8; ++i) { const int n = i * 8 + (lane >> 3), k8 = (lane & 7) * 8; const LAS float* p = scr + k8 * 65 + n;
        u32x2 o; o.x = pk4_fp8(p[0] * sc, p[65] * sc, p[2 * 65] * sc, p[3 * 65] * sc); o.y = pk4_fp8(p[4 * 65] * sc, p[5 * 65] * sc, p[6 * 65] * sc, p[7 * 65] * sc);
        *(u32x2*)(dst + (size_t)(drow0 + n) * ldk + k0 + k8) = o; }
    lds_wait();
}
constexpr int T_MOE1 = 16 * 32 * 16;
struct MoeTile { const float* src; unsigned char* dst; int Nsrc, ldk; };
__device__ __forceinline__ void moe_tile_of(const Args& a, int layer, int it, MoeTile& d) {
    const int which = it / T_MOE1, r = it % T_MOE1, e = r / 512, q = r % 512;
    if (which < 2) {
        const int kt = q % 32, n0 = (q / 32) * 64;
        d.src = (which == 0 ? FIN(I_W1) : FIN(I_W3)) + (size_t)(layer * 16 + e) * 2048 * 1024 + (size_t)(kt * 64) * 1024 + n0; d.Nsrc = 1024;
        d.dst = WSP(unsigned char, WS_MW13) + (size_t)e * 2048 * 2048 + (size_t)((n0 >> 7) * 256 + which * 128 + (n0 & 127)) * 2048 + kt * 64; d.ldk = 2048;
    } else {
        const int kt = q % 16, n0 = (q / 16) * 64;
        d.src = FIN(I_W2) + (size_t)(layer * 16 + e) * 1024 * 2048 + (size_t)(kt * 64) * 2048 + n0; d.Nsrc = 2048;
        d.dst = WSP(unsigned char, WS_MW2) + (size_t)e * 2048 * 1024 + (size_t)n0 * 1024 + kt * 64; d.ldk = 1024;
    }
}
__device__ __forceinline__ void moe_tile_load(const MoeTile& d, f32x4 (&r)[16], int lane) {
#pragma unroll
    for (int i = 0; i < 16; ++i) r[i] = *(const f32x4*)(d.src + (size_t)(i * 4 + (lane >> 4)) * d.Nsrc + (lane & 15) * 4);
}
__device__ __forceinline__ void moe_tile_finish(const MoeTile& d, const f32x4 (&r)[16], LAS float* scr, int lane) {
#pragma unroll
    for (int i = 0; i < 16; ++i) { LAS float* p = scr + (i * 4 + (lane >> 4)) * 65 + (lane & 15) * 4; p[0] = r[i].x; p[1] = r[i].y; p[2] = r[i].z; p[3] = r[i].w; }
    lds_wait();
#pragma unroll
    for (int i = 0; i < 8; ++i) { const int n = i * 8 + (lane >> 3), k8 = (lane & 7) * 8; const LAS float* p = scr + k8 * 65 + n;
        u32x2 o; o.x = pk4_fp8(p[0] * 64.0f, p[65] * 64.0f, p[2 * 65] * 64.0f, p[3 * 65] * 64.0f); o.y = pk4_fp8(p[4 * 65] * 64.0f, p[5 * 65] * 64.0f, p[6 * 65] * 64.0f, p[7 * 65] * 64.0f);
        *(u32x2*)(d.dst + (size_t)n * d.ldk + k8) = o; }
    lds_wait();
}
template <int THROTTLE = 0>
__device__ __forceinline__ void moe_convert_range(const Args& a, int layer, int first, int stride, LAS float* scr, int lane) {
    constexpr int LIM = 3 * T_MOE1; int it = first; if (it >= LIM) return;
    MoeTile dA, dB; f32x4 rA[16], rB[16];
    moe_tile_of(a, layer, it, dA); moe_tile_load(dA, rA, lane);
    for (;;) {
        it += stride; const bool hb = it < LIM; if (hb) { moe_tile_of(a, layer, it, dB); moe_tile_load(dB, rB, lane); }
        moe_tile_finish(dA, rA, scr, lane); if (THROTTLE) { __builtin_amdgcn_s_sleep(127); __builtin_amdgcn_s_sleep(127); __builtin_amdgcn_s_sleep(127); } if (!hb) break;
        it += stride; const bool ha = it < LIM; if (ha) { moe_tile_of(a, layer, it, dA); moe_tile_load(dA, rA, lane); }
        moe_tile_finish(dB, rB, scr, lane); if (THROTTLE) { __builtin_amdgcn_s_sleep(127); __builtin_amdgcn_s_sleep(127); __builtin_amdgcn_s_sleep(127); } if (!ha) break;
    }
}
__device__ __forceinline__ void p0_prologue(const Args& a, LAS unsigned char* lds, int wave, int lane) {
    LAS float* scr = (LAS float*)(lds + LDS_STAGE + wave * 16640);
    const int gw = blockIdx.x * 8 + wave, NGW = gridDim.x * 8;
    if (blockIdx.x == 0 && threadIdx.x < 128) WSP(unsigned, WS_CTL + CTL_CNT)[threadIdx.x] = 0u;
    constexpr int T_WIN0 = 32 * 56, T_WOUT = 32 * 32, T_WIN1 = 32 * 87, T_ADA = 2 * 768, T_SMALL = (2048 + 1024 + 2048) * 256 / 512, T_ROPE = NTOK * 32 / 512, T_PAD = 256;
    constexpr int E0 = 3 * T_MOE1, E1 = E0 + T_ADA, E2 = E1 + T_WIN0, E3 = E2 + T_WOUT, E4 = E3 + T_WIN1, E5 = E4 + T_WOUT, E6 = E5 + T_SMALL, E7 = E6 + T_ROPE, E8 = E7 + T_PAD;
    moe_convert_range(a, 0, gw, NGW, scr, lane);
    for (int it = E0 + gw; it < E8; it += NGW) {
        if (it < E1) {
            const int r = it - E0, layer = r / 768, cg = r % 768, col = cg * 16 + (lane & 3) * 4, kr = lane >> 2;
            const float* W = FIN(I_ADAW) + (size_t)layer * 2048 * 12288 + col; const float* cv = FIN(I_C);
            f32x4 s0 = {0.f, 0.f, 0.f, 0.f}, s1 = s0, s2 = s0, s3 = s0;
            for (int k0 = kr; k0 < 2048; k0 += 128) { f32x4 w[8]; float c0[8], c1[8], c2[8], c3[8];
#pragma unroll
                for (int u = 0; u < 8; ++u) { const int k = k0 + 16 * u; w[u] = *(const f32x4*)(W + (size_t)k * 12288); c0[u] = cv[k]; c1[u] = cv[2048 + k]; c2[u] = cv[4096 + k]; c3[u] = cv[6144 + k]; }
#pragma unroll
                for (int u = 0; u < 8; ++u) { s0 += w[u] * siluf_(c0[u]); s1 += w[u] * siluf_(c1[u]); s2 += w[u] * siluf_(c2[u]); s3 += w[u] * siluf_(c3[u]); } }
#pragma unroll
            for (int o = 4; o <= 32; o <<= 1) {
#pragma unroll
                for (int j = 0; j < 4; ++j) { s0[j] += __shfl_xor(s0[j], o); s1[j] += __shfl_xor(s1[j], o); s2[j] += __shfl_xor(s2[j], o); s3[j] += __shfl_xor(s3[j], o); } }
            if (lane < 4) { const f32x4 bv = *(const f32x4*)(FIN(I_ADAB) + layer * 12288 + col); float* M = WSP(float, WS_CTL + CTL_MOD) + (size_t)layer * 4 * 12288 + col;
                *(f32x4*)M = s0 + bv; *(f32x4*)(M + 12288) = s1 + bv; *(f32x4*)(M + 2 * 12288) = s2 + bv; *(f32x4*)(M + 3 * 12288) = s3 + bv; }
            continue; }
        if (it < E2) { const int r = it - E1; transpose_tile8(FIN(I_ABWIN), AB_IN, (r % 32) * 64, (r / 32) * 64, WSP(unsigned char, WS_WIN0), 2048, (r / 32) * 64, 64.0f, scr, lane); continue; }
        if (it < E3) { const int r = it - E2; transpose_tile8(FIN(I_ABWOUT), 2048, (r % 32) * 64, (r / 32) * 64, WSP(unsigned char, WS_WOUT0), 2048, (r / 32) * 64, 64.0f, scr, lane); continue; }
        if (it < E4) { const int r = it - E3, n0 = (r / 32) * 64;
            transpose_tile8(FIN(I_CDWIN), CD_IN, (r % 32) * 64, n0, WSP(unsigned char, WS_WIN1), 2048, n0 >= 3264 ? n0 + 64 : n0, 64.0f, scr, lane); continue; }
        if (it < E5) { const int r = it - E4; transpose_tile8(FIN(I_CDWOUT), 2048, (r % 32) * 64, (r / 32) * 64, WSP(unsigned char, WS_WOUT1), 2048, (r / 32) * 64, 64.0f, scr, lane); continue; }
        if (it < E6) {
            const int r = (it - E5) * 64 + lane, row = r >> 5, k8 = (r & 31) * 8; float f[8]; bf16_t* dst;
            const float *lw2 = FIN(I_LW2), *la2 = FIN(I_LA2), *lg2 = FIN(I_LG2), *lwa = FIN(I_LWA), *lwx = FIN(I_LWX);
            if (row < 2048) {
                dst = WSP(bf16_t, WS_BWA) + (size_t)row * 256 + k8;
#pragma unroll
                for (int j = 0; j < 8; ++j) { const int k = k8 + j; f[j] = row < 1024 ? (k < 96 ? lw2[k * 1024 + row] : 0.f) : ((k >= 96 && k < 192) ? la2[(k - 96) * 1024 + row - 1024] : 0.f); }
            } else if (row < 3072) {
                const int n = row - 2048; dst = WSP(bf16_t, WS_BG) + (size_t)n * 256 + k8;
#pragma unroll
                for (int j = 0; j < 8; ++j) f[j] = lg2[(k8 + j) * 1024 + n];
            } else {
                const int rr = row - 3072, pn = rr >> 8, half = (rr >> 7) & 1, cc = rr & 127, g = 2 * pn + (cc >> 6), jj = cc & 63, kb = 4 * (pn >> 1);
                dst = WSP(bf16_t, WS_BLRU) + (size_t)rr * 256 + k8; const float* Wg = (half ? lwx : lwa) + (size_t)g * 4096;
#pragma unroll
                for (int j = 0; j < 8; ++j) { const int k = k8 + j; f[j] = ((k >> 6) + kb == g) ? Wg[(k & 63) * 64 + jj] : 0.f; }
            }
            *(u32x4*)dst = pack8(f); continue; }
        if (it < E7) {
            const int r = (it - E6) * 512 + lane * 8, tok = r >> 5, i0 = r & 31; const double pos = (double)((const int*)FIN(I_POS))[tok];
            double fr_ = 1.0; for (int i = 0; i < i0; ++i) fr_ *= 0.74989420933245582730;
            f32x2* dst = WSP(f32x2, WS_ROPE) + (size_t)tok * 32 + i0;
#pragma unroll
            for (int j = 0; j < 8; ++j) { const double rev = pos * fr_ * 0.15915494309189533577; const float fr32 = (float)(rev - __builtin_rint(rev));
                dst[j] = (f32x2){__builtin_amdgcn_cosf(fr32), __builtin_amdgcn_sinf(fr32)}; fr_ *= 0.74989420933245582730; }
            continue; }
        { const int r = (it - E7) * 64 + lane; if (r < 8192) *(u32x4*)(WSP(unsigned char, WS_WIN1) + (size_t)3264 * 2048 + (size_t)r * 16) = (u32x4){0u, 0u, 0u, 0u}; }
    }
}

template <int MODE, bool SRC16, bool H8 = false>
__device__ __forceinline__ void norm_phase(const Args& a, int wave, int lane, const void* xsrc, const float* gn, const float* modv  , int ishift  ,
                                           const float* gatef  ) {
    constexpr bool COMB = MODE & 1, FINAL = (MODE & 4) != 0;
    const int gw = blockIdx.x * 8 + wave, WPB = gridDim.x * 2, b = gw / WPB, wb = gw - b * WPB;
    f32x4 PA[8], PB[8], GF[8];
    { const f32x4* gp = (const f32x4*)gn + lane;
      if (FINAL) {
#pragma unroll
          for (int j = 0; j < 8; ++j) { PA[j] = gp[64 * j]; PB[j] = (f32x4){0.f, 0.f, 0.f, 0.f}; } }
      else { const f32x4* shp = (const f32x4*)(modv + (size_t)b * 12288 + ishift * DM) + lane; const f32x4* scp = (const f32x4*)(modv + (size_t)b * 12288 + (ishift + 1) * DM) + lane;
#pragma unroll
          for (int j = 0; j < 8; ++j) { PA[j] = gp[64 * j] * (scp[64 * j] + 1.0f); PB[j] = shp[64 * j]; } }
      if (COMB) { const f32x4* gf = (const f32x4*)(gatef + (size_t)b * 12288) + lane;
#pragma unroll
          for (int j = 0; j < 8; ++j) GF[j] = gf[64 * j]; } }
    for (int i = wb; i < SEQ; i += WPB) { const int m = b * SEQ + i;
        f32x4 v[8];
        if (SRC16) { const u32x2* xr = (const u32x2*)((const bf16_t*)xsrc + (size_t)m * DM) + lane;
#pragma unroll
            for (int j = 0; j < 8; ++j) { const u32x2 w = xr[64 * j]; v[j] = (f32x4){bflo(w.x), bfhi(w.x), bflo(w.y), bfhi(w.y)}; } }
        else { const f32x4* xr = (const f32x4*)((const float*)xsrc + (size_t)m * DM) + lane;
#pragma unroll
            for (int j = 0; j < 8; ++j) v[j] = xr[64 * j]; }
        if (COMB) {
            const int2 pp = WSP(int2, WS_TOKP)[m]; const f32x2 gg = WSP(f32x2, WS_TOKG)[m];
            const unsigned* y0 = (const unsigned*)(WSP(unsigned char, WS_YB) + (size_t)pp.x * DM) + lane; const unsigned* y1 = (const unsigned*)(WSP(unsigned char, WS_YB) + (size_t)pp.y * DM) + lane;
            u32x2* xo = (u32x2*)((bf16_t*)xsrc + (size_t)m * DM) + lane; const float g0s = gg.x * (1.0f / 32.0f), g1s = gg.y * (1.0f / 32.0f);
#pragma unroll
            for (int j = 0; j < 8; ++j) { const unsigned p0 = y0[64 * j], p1 = y1[64 * j];
                const f32x2 a0 = __builtin_amdgcn_cvt_pk_f32_fp8((int)p0, false), a1 = __builtin_amdgcn_cvt_pk_f32_fp8((int)p0, true), b0 = __builtin_amdgcn_cvt_pk_f32_fp8((int)p1, false), b1 = __builtin_amdgcn_cvt_pk_f32_fp8((int)p1, true);
                f32x4 yv; yv.x = g0s * a0.x + g1s * b0.x; yv.y = g0s * a0.y + g1s * b0.y; yv.z = g0s * a1.x + g1s * b1.x; yv.w = g0s * a1.y + g1s * b1.y;
                v[j] += GF[j] * yv; if (!FINAL) { u32x2 o; o.x = pk2(v[j].x, v[j].y); o.y = pk2(v[j].z, v[j].w); xo[64 * j] = o; } } }
        float ss = 0.f;
#pragma unroll
        for (int j = 0; j < 8; ++j) ss += (v[j].x * v[j].x + v[j].y * v[j].y) + (v[j].z * v[j].z + v[j].w * v[j].w);
        const float rs = __builtin_amdgcn_rsqf(wave_sum(ss) * (1.0f / DM) + 1e-6f);
        if (FINAL) { f32x4* xo = (f32x4*)(a.out + (size_t)m * DM) + lane;
#pragma unroll
            for (int j = 0; j < 8; ++j) xo[64 * j] = v[j] * rs * PA[j];
            continue; }
#pragma unroll
        for (int j = 0; j < 8; ++j) { const f32x4 h = (v[j] * rs) * PA[j] + PB[j];
            if (H8) ((unsigned*)(WSP(unsigned char, WS_H) + (size_t)m * DM))[lane + 64 * j] = pk4_fp8(h.x, h.y, h.z, h.w);
            else { u32x2 o; o.x = pk2(h.x, h.y); o.y = pk2(h.z, h.w); ((u32x2*)(WSP(bf16_t, WS_H) + (size_t)m * DM) + lane)[64 * j] = o; } }
    }
}

__device__ __forceinline__ void route_pick(const Args& a, const float (&L)[16], int m, bool writer, const float* rbias, LAS unsigned* hist) {
    float mx = L[0];
#pragma unroll
    for (int e = 1; e < 16; ++e) mx = fmaxf(mx, L[e]);
    float P[16], sum = 0.f;
#pragma unroll
    for (int e = 0; e < 16; ++e) { P[e] = __expf(L[e] - mx); sum += P[e]; }
    const float inv = 1.0f / sum; float sel[16];
#pragma unroll
    for (int e = 0; e < 16; ++e) { P[e] *= inv; sel[e] = P[e] + rbias[e]; }
    int gbest = 0; float gsc = -1e30f;
#pragma unroll
    for (int g = 0; g < 4; ++g) { const float x0 = sel[4 * g], x1 = sel[4 * g + 1], x2 = sel[4 * g + 2], x3 = sel[4 * g + 3];
        const float m1 = fmaxf(x0, x1), n1 = fminf(x0, x1), m2 = fmaxf(x2, x3), n2 = fminf(x2, x3);
        const float sc = fmaxf(m1, m2) + fmaxf(fminf(m1, m2), fmaxf(n1, n2)); if (sc > gsc) { gsc = sc; gbest = g; } }
    float s4[4], p4[4];
#pragma unroll
    for (int i = 0; i < 4; ++i) { s4[i] = 0.f; p4[i] = 0.f; }
#pragma unroll
    for (int g = 0; g < 4; ++g)
#pragma unroll
        for (int i = 0; i < 4; ++i) { s4[i] = (g == gbest) ? sel[4 * g + i] : s4[i]; p4[i] = (g == gbest) ? P[4 * g + i] : p4[i]; }
    int i1 = 0; float b1 = s4[0];
#pragma unroll
    for (int i = 1; i < 4; ++i) if (s4[i] > b1) { b1 = s4[i]; i1 = i; }
    int i2 = -1; float b2 = -1e30f;
#pragma unroll
    for (int i = 0; i < 4; ++i) if (i != i1 && s4[i] > b2) { b2 = s4[i]; i2 = i; }
    float g1 = 0.f, g2 = 0.f;
#pragma unroll
    for (int i = 0; i < 4; ++i) { g1 = (i == i1) ? p4[i] : g1; g2 = (i == i2) ? p4[i] : g2; }
    const float gi = 1.0f / (g1 + g2);
    if (writer) { const int e1 = gbest * 4 + i1, e2 = gbest * 4 + i2;
        WSP(int2, WS_TOKE)[m] = make_int2(e1, e2); WSP(f32x2, WS_TOKG)[m] = (f32x2){g1 * gi, g2 * gi};
        __hip_atomic_fetch_add(&hist[e1], 1u, __ATOMIC_RELAXED, __HIP_MEMORY_SCOPE_WORKGROUP); __hip_atomic_fetch_add(&hist[e2], 1u, __ATOMIC_RELAXED, __HIP_MEMORY_SCOPE_WORKGROUP); }
}
__device__ __forceinline__ void route_norm_phase(const Args& a, LAS unsigned char* lds, int wave, int lane, const bf16_t* xsrc, const float* gn, const float* modv  , int ishift, int cnt_layer) {
    LAS float* rwB = (LAS float*)(lds + LDS_STAGE); LAS float* PAl = (LAS float*)(lds + LDS_STAGE + 131072); LAS float* PBl = PAl + 2048;
    LAS unsigned* hist = (LAS unsigned*)(lds + MISC_HIST);
    const float* rbias = FIN(I_RB);
    const int BPB = gridDim.x >> 2, b = blockIdx.x / BPB, bi = blockIdx.x - b * BPB;
    if (b >= NB) return;
    { const float* rw = FIN(I_RW);
      for (int idx = threadIdx.x; idx < 2048 * 16; idx += 512) { const int k = idx >> 4, n = idx & 15; rwB[((((k >> 6) * 4 + ((k >> 2) & 3)) * 64 + ((k >> 4) & 3) * 16 + n) << 2) + (k & 3)] = rw[idx]; }
      const float* sh = modv + (size_t)b * 12288 + ishift * DM;
      for (int idx = threadIdx.x; idx < DM; idx += 512) { PAl[idx] = gn[idx] * (sh[DM + idx] + 1.0f); PBl[idx] = sh[idx]; }
      if (threadIdx.x < 16) hist[threadIdx.x] = 0u;
      __syncthreads(); }
    const int ti = lane & 15, kq = lane >> 4;
    for (int g = bi * 8 + wave; g < SEQ / 16; g += BPB * 8) {
        const int m0 = b * SEQ + g * 16; const bf16_t* xr = xsrc + (size_t)(m0 + ti) * DM + 16 * kq;
        float ss = 0.f;
#pragma unroll 1
        for (int c0 = 0; c0 < 32; c0 += 8) { u32x4 r[8][2];
#pragma unroll
            for (int u = 0; u < 8; ++u) { const u32x4* p = (const u32x4*)(xr + 64 * (c0 + u)); r[u][0] = p[0]; r[u][1] = p[1]; }
#pragma unroll
            for (int u = 0; u < 8; ++u) { float f[8]; unpack8(r[u][0], f);
#pragma unroll
                for (int j = 0; j < 8; ++j) ss += f[j] * f[j];
                unpack8(r[u][1], f);
#pragma unroll
                for (int j = 0; j < 8; ++j) ss += f[j] * f[j]; } }
        ss += __shfl_xor(ss, 16); ss += __shfl_xor(ss, 32);
        const float rs = __builtin_amdgcn_rsqf(ss * (1.0f / DM) + 1e-6f);
        f32x4 acc = {0.f, 0.f, 0.f, 0.f};
        unsigned char* hrow = WSP(unsigned char, WS_H) + (size_t)(m0 + ti) * DM + 16 * kq;
#pragma unroll 1
        for (int c0 = 0; c0 < 32; c0 += 8) { u32x4 r[8][2];
#pragma unroll
            for (int u = 0; u < 8; ++u) { const u32x4* p = (const u32x4*)(xr + 64 * (c0 + u)); r[u][0] = p[0]; r[u][1] = p[1]; }
#pragma unroll
            for (int u = 0; u < 8; ++u) { const int c = c0 + u; float x0[8], x1[8], h[16]; unpack8(r[u][0], x0); unpack8(r[u][1], x1);
#pragma unroll
                for (int q4 = 0; q4 < 4; ++q4) { const f32x4 pa = *(const LAS f32x4*)(PAl + 64 * c + 16 * kq + 4 * q4), pb = *(const LAS f32x4*)(PBl + 64 * c + 16 * kq + 4 * q4);
#pragma unroll
                    for (int s = 0; s < 4; ++s) { const float xv = q4 < 2 ? x0[4 * q4 + s] : x1[4 * (q4 - 2) + s]; h[4 * q4 + s] = (xv * rs) * pa[s] + pb[s]; } }
                u32x4 w; w.x = pk4_fp8(h[0], h[1], h[2], h[3]); w.y = pk4_fp8(h[4], h[5], h[6], h[7]); w.z = pk4_fp8(h[8], h[9], h[10], h[11]); w.w = pk4_fp8(h[12], h[13], h[14], h[15]);
                *(u32x4*)(hrow + 64 * c) = w;
#pragma unroll
                for (int g4 = 0; g4 < 4; ++g4) { const f32x4 bv = *(const LAS f32x4*)(rwB + (size_t)(((c * 4 + g4) * 64 + lane) << 2));
#pragma unroll
                    for (int s = 0; s < 4; ++s) acc = __builtin_amdgcn_mfma_f32_16x16x4f32(h[4 * g4 + s], bv[s], acc, 0, 0, 0); } } }
#pragma unroll
        for (int r = 0; r < 4; ++r) { float L[16];
#pragma unroll
            for (int e = 0; e < 16; ++e) L[e] = __shfl(acc[r], (lane & 48) + e);
            route_pick(a, L, m0 + 4 * kq + r, ti == 0, rbias, hist); }
    }
    __syncthreads(); if (threadIdx.x < 16) atomicAdd(WSP(unsigned, WS_CTL + CTL_CNT) + cnt_layer * 16 + threadIdx.x, hist[threadIdx.x]);
}

__device__ __forceinline__ void moe_tile_starts(const Args& a, LAS unsigned char* lds, int layer) {
    LAS int* ts = (LAS int*)(lds + MISC_TSTART);
    if (threadIdx.x == 0) { int acc = 0; const unsigned* cnt = WSP(unsigned, WS_CTL + CTL_CNT) + layer * 16;
        for (int e = 0; e < 16; ++e) { ts[e] = acc; acc += (int)((__hip_atomic_load(cnt + e, __ATOMIC_RELAXED, __HIP_MEMORY_SCOPE_AGENT) + 255u) >> 8); } ts[16] = acc; }
    __syncthreads();
}
__device__ __forceinline__ void moe_assign_phase(const Args& a, LAS unsigned char* lds, int wave, int lane, int layer) {
    LAS int* ts = (LAS int*)(lds + MISC_TSTART); LAS unsigned* hist = (LAS unsigned*)(lds + MISC_HIST); LAS unsigned* bbase = (LAS unsigned*)(lds + MISC_BBASE);
    moe_tile_starts(a, lds, layer);
    const int tid = threadIdx.x;
    for (int chunk = blockIdx.x; chunk < NTOK / 128; chunk += gridDim.x) {
        if (tid < 16) hist[tid] = 0u;
        __syncthreads();
        int e = 0, rank = 0; const int tok = chunk * 128 + (tid >> 1);
        if (tid < 256) { const int2 ee = WSP(int2, WS_TOKE)[tok]; e = (tid & 1) ? ee.y : ee.x; rank = (int)__hip_atomic_fetch_add(&hist[e], 1u, __ATOMIC_RELAXED, __HIP_MEMORY_SCOPE_WORKGROUP); }
        __syncthreads();
        if (tid < 16) bbase[tid] = atomicAdd(WSP(unsigned, WS_CTL + CTL_CUR) + layer * 16 + tid, hist[tid]);
        __syncthreads();
        if (tid < 256) { const int pos = ts[e] * 256 + (int)bbase[e] + rank; ((int*)WSP(int2, WS_TOKP))[tok * 2 + (tid & 1)] = pos; WSP(int, WS_ROWTOK)[pos] = tok; }
        __syncthreads();
    }
    { const unsigned* cnt = WSP(unsigned, WS_CTL + CTL_CNT) + layer * 16;
      for (int e = blockIdx.x; e < 16; e += gridDim.x) { const int c = (int)__hip_atomic_load(cnt + e, __ATOMIC_RELAXED, __HIP_MEMORY_SCOPE_AGENT), end = ((c + 255) >> 8) << 8;
          for (int r = c + tid; r < end; r += 512) WSP(int, WS_ROWTOK)[ts[e] * 256 + r] = 0; } }
}

template <bool GATHER_> struct MoeSchedT {
    static constexpr bool GATHER = GATHER_;
    int nM, nN, G, c; const LAS int* ts; const char* A; const char* B; size_t tA, tB, eB; const int* rowtab;
    __device__ __forceinline__ const char* gbase() const { return A; }
    __device__ __forceinline__ bool next(int i, g8::Unit& u) const { u.kind = 0; if (!g8::tile_of((long)i * G + c, nM, nN, u.pm, u.pn)) return false;
        int e = 0;
#pragma unroll
        for (int q = 1; q < 16; ++q) e += (u.pm >= ts[q]) ? 1 : 0;
        u.e = __builtin_amdgcn_readfirstlane(e); u.pm = __builtin_amdgcn_readfirstlane(u.pm); u.pn = __builtin_amdgcn_readfirstlane(u.pn); return true; }
    __device__ __forceinline__ const char* abase(const g8::Unit& u) const { return A + (size_t)u.pm * tA; }
    __device__ __forceinline__ const char* bbase(const g8::Unit& u) const { return B + (size_t)u.e * eB + (size_t)u.pn * tB; }
};
struct MultiSched {
    static constexpr bool GATHER = false;
    int G, c; const char* A; const char* ws;
    __device__ __forceinline__ bool next(int i, g8::Unit& u) const { const long L = (long)i * G + c; u.e = 0;
        if (L < 1024) { u.kind = 0; return g8::tile_of(L, 128, 8, u.pm, u.pn); }
        if (L < 1536) { u.kind = 1; return g8::tile_of(L - 1024, 128, 4, u.pm, u.pn); }
        u.kind = 2; return g8::tile_of(L - 1536, 128, 8, u.pm, u.pn); }
    __device__ __forceinline__ const char* abase(const g8::Unit& u) const { const int k1 = u.kind >= 1 ? 1 : 0, k2 = u.kind >= 2 ? 1 : 0; const int coff = 256 * k1 + k2 * (256 + 256 * (u.pn >> 1)); return A + ((size_t)u.pm * 256 * 1536 + coff) * 2; }
    __device__ __forceinline__ const char* bbase(const g8::Unit& u) const { const size_t k1 = u.kind >= 1 ? 1 : 0, k2 = u.kind >= 2 ? 1 : 0;
        return ws + WS_BWA + k1 * (WS_BG - WS_BWA) + k2 * (WS_BLRU - WS_BG) + (size_t)u.pn * 256 * 256 * 2; }
};
template <bool F8_> struct EpiBf16T {
    static constexpr bool PERM = true, F8 = F8_; static constexpr int SC_A = 0x7f7f7f7f, SC_B = 0x79797979; bf16_t* O; int ldc;
    __device__ __forceinline__ void operator()(const f32x4 (&acc)[2][2][4][2], const g8::Unit& u, int wr, int wc, int fr, int fq) const {
        const int row0 = u.pm * 256 + wr * 64 + fr, col0 = u.pn * 256 + wc * 32 + 8 * fq;
#pragma unroll
        for (int ai = 0; ai < 2; ++ai)
#pragma unroll
            for (int m = 0; m < 4; ++m) { bf16_t* rowp = O + (size_t)(row0 + ai * 128 + m * 16) * ldc + col0;
#pragma unroll
                for (int bj = 0; bj < 2; ++bj) { const f32x4 v0 = acc[ai][bj][m][0], v1 = acc[ai][bj][m][1];
                    u32x4 w; w.x = pk2(v0[0], v0[1]); w.y = pk2(v0[2], v0[3]); w.z = pk2(v1[0], v1[1]); w.w = pk2(v1[2], v1[3]); *(u32x4*)(rowp + bj * 128) = w; } }
    }
};
template <bool IN16> struct EpiResid {
    static constexpr bool PERM = true, F8 = true; static constexpr int SC_A = 0x7c7c7c7c, SC_B = 0x79797979; const void* xin; bf16_t* xout; const float* gate;
    __device__ __forceinline__ void operator()(const f32x4 (&acc)[2][2][4][2], const g8::Unit& u, int wr, int wc, int fr, int fq) const {
        const int row0 = u.pm * 256 + wr * 64 + fr, col0 = u.pn * 256 + wc * 32 + 8 * fq; const float* gp = gate + (size_t)(u.pm >> 5) * 12288 + col0;
        f32x4 gv[2][2];
#pragma unroll
        for (int bj = 0; bj < 2; ++bj)
#pragma unroll
            for (int n = 0; n < 2; ++n) gv[bj][n] = *(const f32x4*)(gp + bj * 128 + n * 4);
#pragma unroll
        for (int ai = 0; ai < 2; ++ai) { f32x4 xv[4][2][2];
#pragma unroll
            for (int m = 0; m < 4; ++m) { const size_t off = (size_t)(row0 + ai * 128 + m * 16) * DM + col0;
#pragma unroll
                for (int bj = 0; bj < 2; ++bj) {
                    if (IN16) { const u32x4 w = *(const u32x4*)((const bf16_t*)xin + off + bj * 128); xv[m][bj][0] = (f32x4){bflo(w.x), bfhi(w.x), bflo(w.y), bfhi(w.y)}; xv[m][bj][1] = (f32x4){bflo(w.z), bfhi(w.z), bflo(w.w), bfhi(w.w)}; }
                    else { xv[m][bj][0] = *(const f32x4*)((const float*)xin + off + bj * 128); xv[m][bj][1] = *(const f32x4*)((const float*)xin + off + bj * 128 + 4); } } }
            asm volatile("" ::: "memory");
#pragma unroll
            for (int m = 0; m < 4; ++m) { const size_t off = (size_t)(row0 + ai * 128 + m * 16) * DM + col0;
#pragma unroll
                for (int bj = 0; bj < 2; ++bj) { const f32x4 v0 = xv[m][bj][0] + gv[bj][0] * acc[ai][bj][m][0], v1 = xv[m][bj][1] + gv[bj][1] * acc[ai][bj][m][1];
                    u32x4 w; w.x = pk2(v0[0], v0[1]); w.y = pk2(v0[2], v0[3]); w.z = pk2(v1[0], v1[1]); w.w = pk2(v1[2], v1[3]); *(u32x4*)(xout + off + bj * 128) = w; } }
            asm volatile("" ::: "memory"); }
    }
};
struct EpiHid {
    static constexpr bool PERM = true, F8 = true; static constexpr int SC_A = 0x7f7f7f7f, SC_B = 0x79797979;
    unsigned char* O;
    __device__ __forceinline__ void operator()(const f32x4 (&acc)[2][2][4][2], const g8::Unit& u, int wr, int wc, int fr, int fq) const {
        const int row0 = u.pm * 256 + wr * 64 + fr, col0 = u.pn * 128 + wc * 32 + 8 * fq;
#pragma unroll
        for (int ai = 0; ai < 2; ++ai)
#pragma unroll
            for (int m = 0; m < 4; ++m) { float f[8];
#pragma unroll
                for (int n = 0; n < 2; ++n)
#pragma unroll
                    for (int i = 0; i < 4; ++i) f[n * 4 + i] = 4.0f * siluf_(acc[ai][0][m][n][i]) * acc[ai][1][m][n][i];
                u32x2 w; w.x = pk4_fp8(f[0], f[1], f[2], f[3]); w.y = pk4_fp8(f[4], f[5], f[6], f[7]);
                *(u32x2*)(O + (size_t)(row0 + ai * 128 + m * 16) * DEXP + col0) = w; }
    }
};
struct EpiY8 {
    static constexpr bool PERM = true, F8 = true; static constexpr int SC_A = 0x7f7f7f7f, SC_B = 0x7c7c7c7c; unsigned char* O; int ldc;
    __device__ __forceinline__ void operator()(const f32x4 (&acc)[2][2][4][2], const g8::Unit& u, int wr, int wc, int fr, int fq) const {
        const int row0 = u.pm * 256 + wr * 64 + fr, col0 = u.pn * 256 + wc * 32 + 8 * fq;
#pragma unroll
        for (int ai = 0; ai < 2; ++ai)
#pragma unroll
            for (int m = 0; m < 4; ++m) { unsigned char* rowp = O + (size_t)(row0 + ai * 128 + m * 16) * ldc + col0;
#pragma unroll
                for (int bj = 0; bj < 2; ++bj) { const f32x4 v0 = acc[ai][bj][m][0], v1 = acc[ai][bj][m][1];
                    u32x2 w; w.x = pk4_fp8(v0[0], v0[1], v0[2], v0[3]); w.y = pk4_fp8(v1[0], v1[1], v1[2], v1[3]); *(u32x2*)(rowp + bj * 128) = w; } }
    }
};
struct EpiL1 {
    static constexpr bool PERM = true, F8 = false; static constexpr int SC_A = 0, SC_B = 0;
    bf16_t *LD, *RKV, *KK, *BB, *GG, *LOGA, *UU; const bf16_t* LIN; const float *w0, *a0, *ka, *ba, *bx, *lam;
    __device__ __forceinline__ void operator()(const f32x4 (&acc)[2][2][4][2], const g8::Unit& u, int wr, int wc, int fr, int fq) const {
        const int row0 = u.pm * 256 + wr * 64 + fr;
        if (u.kind == 2) {
            const int ch0 = u.pn * 128 + wc * 32 + 8 * fq; float bav[8], bxv[8], spl[8];
#pragma unroll
            for (int i = 0; i < 8; ++i) { bav[i] = ba[ch0 + i]; bxv[i] = bx[ch0 + i]; spl[i] = -8.0f * softplusf_(-lam[ch0 + i]); }
#pragma unroll
            for (int ai = 0; ai < 2; ++ai) { u32x4 xr[4];
#pragma unroll
                for (int m = 0; m < 4; ++m) xr[m] = *(const u32x4*)(LIN + (size_t)(row0 + ai * 128 + m * 16) * 1536 + 512 + ch0);
                asm volatile("" ::: "memory");
#pragma unroll
                for (int m = 0; m < 4; ++m) { const size_t row = (size_t)(row0 + ai * 128 + m * 16); float xb[8], la[8], uu[8];
                    unpack8(xr[m], xb);
#pragma unroll
                    for (int n = 0; n < 2; ++n)
#pragma unroll
                        for (int i = 0; i < 4; ++i) { const int q = n * 4 + i; const float r = sigmoidf_(acc[ai][0][m][n][i] + bav[q]), ig = sigmoidf_(acc[ai][1][m][n][i] + bxv[q]);
                            const float l = spl[q] * r; la[q] = l; uu[q] = __builtin_sqrtf(fmaxf(1.0f - fast_exp(2.0f * l), 0.0f)) * (ig * xb[q]); }
                    *(u32x4*)(LOGA + row * 1024 + ch0) = pack8(la); *(u32x4*)(UU + row * 1024 + ch0) = pack8(uu); }
                asm volatile("" ::: "memory"); }
            return; }
#pragma unroll
        for (int bj = 0; bj < 2; ++bj) {
            const int colt = u.pn * 256 + bj * 128 + wc * 32 + 8 * fq;
            if (u.kind == 1) {
#pragma unroll
                for (int ai = 0; ai < 2; ++ai)
#pragma unroll
                    for (int m = 0; m < 4; ++m) { float f[8];
#pragma unroll
                        for (int q = 0; q < 8; ++q) f[q] = acc[ai][bj][m][q >> 2][q & 3];
                        *(u32x4*)(GG + (size_t)(row0 + ai * 128 + m * 16) * 1024 + colt) = pack8(f); asm volatile("" ::: "memory"); }
            } else if (colt < 1024) {
                float w0v[8];
#pragma unroll
                for (int q = 0; q < 8; ++q) w0v[q] = w0[colt + q];
#pragma unroll
                for (int ai = 0; ai < 2; ++ai)
#pragma unroll
                    for (int m = 0; m < 4; ++m) { float f[8];
#pragma unroll
                        for (int q = 0; q < 8; ++q) { const float w = -softplusf_(-(w0v[q] + acc[ai][bj][m][q >> 2][q & 3])) - 0.5f; f[q] = -fast_exp(w); }
                        *(u32x4*)(LD + (size_t)(row0 + ai * 128 + m * 16) * 1024 + colt) = pack8(f); asm volatile("" ::: "memory"); }
            } else {
                const int ch0 = colt - 1024; float a0v[8], kav[8];
#pragma unroll
                for (int q = 0; q < 8; ++q) { a0v[q] = a0[ch0 + q]; kav[q] = ka[ch0 + q]; }
#pragma unroll
                for (int ai = 0; ai < 2; ++ai) { u32x4 kr[4], kkr[4];
#pragma unroll
                    for (int m = 0; m < 4; ++m) { const size_t row = (size_t)(row0 + ai * 128 + m * 16); kr[m] = *(const u32x4*)(RKV + row * 3072 + 1024 + ch0); kkr[m] = *(const u32x4*)(KK + row * 1024 + ch0); }
                    asm volatile("" ::: "memory");
#pragma unroll
                    for (int m = 0; m < 4; ++m) { const size_t row = (size_t)(row0 + ai * 128 + m * 16); float kl[8], kkv[8], kp[8], bb[8];
                        unpack8(kr[m], kl); unpack8(kkr[m], kkv);
#pragma unroll
                        for (int q = 0; q < 8; ++q) { const float av = sigmoidf_(a0v[q] + acc[ai][bj][m][q >> 2][q & 3]); kp[q] = kl[q] * (1.0f + (av - 1.0f) * kav[q]); bb[q] = kkv[q] * av; }
                        *(u32x4*)(RKV + row * 3072 + 1024 + ch0) = pack8(kp); *(u32x4*)(BB + row * 1024 + ch0) = pack8(bb); }
                    asm volatile("" ::: "memory"); }
            }
        }
    }
};
constexpr int KS_PITCH = 72, VT_PITCH = 260;
__device__ __forceinline__ void attn_unit(const Args& a, LAS unsigned char* lds, int unit, int wave, int lane) {
    const bf16_t* Z = WSP(bf16_t, WS_Z); const f32x2* ROPE = WSP(f32x2, WS_ROPE); unsigned char* CAT = WSP(unsigned char, WS_CAT0);
    LAS bf16_t* Ks = (LAS bf16_t*)(lds + LDS_STAGE); LAS bf16_t* Vt = Ks + 256 * KS_PITCH;
    const int b = unit >> 8, nblk = (unit >> 2) & 63, kvh = unit & 3, tid = threadIdx.x;
    const int tok0 = b * SEQ + nblk * 128;
    const int head = kvh * 4 + (wave >> 1), l31 = lane & 31, h = lane >> 5;
    bf16x8 qfa[2][4];
#pragma unroll
    for (int rt = 0; rt < 2; ++rt) { const size_t tok = (size_t)(tok0 + ((wave & 1) * 2 + rt) * 32 + l31);
        float q[4][8]; const bf16_t* qp = Z + tok * AB_IN + head * 64 + 8 * h;
#pragma unroll
        for (int s = 0; s < 4; ++s) unpack8(*(const u32x4*)(qp + 16 * s), q[s]);
#pragma unroll
        for (int s = 0; s < 2; ++s) { const f32x4* cs = (const f32x4*)(ROPE + tok * 32 + 16 * s + 8 * h); float ol[8], oh[8];
#pragma unroll
            for (int j = 0; j < 4; ++j) { const f32x4 c2 = cs[j];
                ol[2 * j] = (q[s][2 * j] * c2.x - q[s + 2][2 * j] * c2.y) * 0.125f; oh[2 * j] = (q[s + 2][2 * j] * c2.x + q[s][2 * j] * c2.y) * 0.125f;
                ol[2 * j + 1] = (q[s][2 * j + 1] * c2.z - q[s + 2][2 * j + 1] * c2.w) * 0.125f; oh[2 * j + 1] = (q[s + 2][2 * j + 1] * c2.z + q[s][2 * j + 1] * c2.w) * 0.125f; }
            const u32x4 pl = pack8(ol), ph = pack8(oh); qfa[rt][s] = __builtin_bit_cast(bf16x8, pl); qfa[rt][s + 2] = __builtin_bit_cast(bf16x8, ph); } }
    __syncthreads();
#pragma unroll
    for (int i = 0; i < 2; ++i) { const int pp = tid + 512 * i, key = pp >> 2, d0 = (pp & 3) * 8; float lo[8], hi[8], ol[8], oh[8];
        if (nblk == 0 && key < 128) {
#pragma unroll
            for (int j = 0; j < 8; ++j) { ol[j] = 0.f; oh[j] = 0.f; }
        } else { const size_t row = (size_t)(tok0 - 128 + key); const bf16_t* kp = Z + row * AB_IN + 1024 + kvh * 64 + d0;
            unpack8(*(const u32x4*)kp, lo); unpack8(*(const u32x4*)(kp + 32), hi); const f32x4* cs = (const f32x4*)(ROPE + row * 32 + d0);
#pragma unroll
            for (int j = 0; j < 4; ++j) { const f32x4 c2 = cs[j];
                ol[2 * j] = lo[2 * j] * c2.x - hi[2 * j] * c2.y; oh[2 * j] = hi[2 * j] * c2.x + lo[2 * j] * c2.y;
                ol[2 * j + 1] = lo[2 * j + 1] * c2.z - hi[2 * j + 1] * c2.w; oh[2 * j + 1] = hi[2 * j + 1] * c2.z + lo[2 * j + 1] * c2.w; } }
        *(LAS u32x4*)(Ks + key * KS_PITCH + d0) = pack8(ol); *(LAS u32x4*)(Ks + key * KS_PITCH + d0 + 32) = pack8(oh); }
#pragma unroll
    for (int i = 0; i < 4; ++i) { const int p = tid + 512 * i, key = p >> 3, d0 = (p & 7) * 8; u32x4 w = {0u, 0u, 0u, 0u};
        if (!(nblk == 0 && key < 128)) w = *(const u32x4*)(Z + (size_t)(tok0 - 128 + key) * AB_IN + 1280 + kvh * 64 + d0);
        LAS bf16_t* vp = Vt + d0 * VT_PITCH + key;
        vp[0] = (bf16_t)(w.x & 0xffff); vp[VT_PITCH] = (bf16_t)(w.x >> 16); vp[2 * VT_PITCH] = (bf16_t)(w.y & 0xffff); vp[3 * VT_PITCH] = (bf16_t)(w.y >> 16);
        vp[4 * VT_PITCH] = (bf16_t)(w.z & 0xffff); vp[5 * VT_PITCH] = (bf16_t)(w.z >> 16); vp[6 * VT_PITCH] = (bf16_t)(w.w & 0xffff); vp[7 * VT_PITCH] = (bf16_t)(w.w >> 16); }
    __syncthreads();
    const float sink = FIN(I_SINKS)[head];
#pragma unroll
    for (int rt = 0; rt < 2; ++rt) {
        const int r = (wave & 1) * 2 + rt, qi = r * 32 + l31; const size_t tok = (size_t)(tok0 + qi);
        const bf16x8 (&qf)[4] = qfa[rt];
        f32x16 sc[5];
#pragma unroll
        for (int kt = 0; kt < 5; ++kt) {
#pragma unroll
            for (int i = 0; i < 16; ++i) sc[kt][i] = 0.f;
            const LAS bf16_t* kp = Ks + ((r + kt) * 32 + l31) * KS_PITCH + 8 * h;
#pragma unroll
            for (int s = 0; s < 4; ++s) { const bf16x8 kf = *(const LAS bf16x8*)(kp + 16 * s); sc[kt] = __builtin_amdgcn_mfma_f32_32x32x16_bf16(kf, qf[s], sc[kt], 0, 0, 0); } }
        float mx = -1e30f;
#pragma unroll
        for (int kt = 0; kt < 5; ++kt)
#pragma unroll
            for (int i = 0; i < 16; ++i) { const int kj = (r + kt) * 32 + (i & 3) + 8 * (i >> 2) + 4 * h; const bool valid = (kj > qi) && (kj <= qi + 128) && (nblk > 0 || kj >= 128);
                const float s = valid ? sc[kt][i] : -1e30f; sc[kt][i] = s; mx = fmaxf(mx, s); }
        mx = fmaxf(mx, __shfl_xor(mx, 32)); const float mfin = fmaxf(mx, sink); float lsum = 0.f;
#pragma unroll
        for (int kt = 0; kt < 5; ++kt)
#pragma unroll
            for (int i = 0; i < 16; ++i) { const float p = __builtin_amdgcn_exp2f((sc[kt][i] - mfin) * LOG2E); sc[kt][i] = p; lsum += p; }
        lsum += __shfl_xor(lsum, 32); const float inv = fast_rcp(lsum + __builtin_amdgcn_exp2f((sink - mfin) * LOG2E));
        f32x16 oa[2];
#pragma unroll
        for (int dt = 0; dt < 2; ++dt)
#pragma unroll
            for (int i = 0; i < 16; ++i) oa[dt][i] = 0.f;
#pragma unroll
        for (int kt = 0; kt < 5; ++kt)
#pragma unroll
            for (int s2 = 0; s2 < 2; ++s2) { u32x4 pw; pw.x = pk2(sc[kt][8 * s2], sc[kt][8 * s2 + 1]); pw.y = pk2(sc[kt][8 * s2 + 2], sc[kt][8 * s2 + 3]); pw.z = pk2(sc[kt][8 * s2 + 4], sc[kt][8 * s2 + 5]); pw.w = pk2(sc[kt][8 * s2 + 6], sc[kt][8 * s2 + 7]);
                const bf16x8 pf = __builtin_bit_cast(bf16x8, pw); const int kb = (r + kt) * 32 + 16 * s2 + 4 * h;
#pragma unroll
                for (int dt = 0; dt < 2; ++dt) { const LAS bf16_t* vp = Vt + (dt * 32 + l31) * VT_PITCH + kb; u32x4 vw; const u32x2 v0 = *(const LAS u32x2*)vp, v1 = *(const LAS u32x2*)(vp + 8);
                    vw.x = v0.x; vw.y = v0.y; vw.z = v1.x; vw.w = v1.y; oa[dt] = __builtin_amdgcn_mfma_f32_32x32x16_bf16(__builtin_bit_cast(bf16x8, vw), pf, oa[dt], 0, 0, 0); } }
        unsigned char* op = CAT + tok * DM + head * 64 + 4 * h; const float inv8 = inv * 8.0f;
#pragma unroll
        for (int dt = 0; dt < 2; ++dt)
#pragma unroll
            for (int g = 0; g < 4; ++g) *(unsigned*)(op + dt * 32 + 8 * g) = pk4_fp8(oa[dt][4 * g] * inv8, oa[dt][4 * g + 1] * inv8, oa[dt][4 * g + 2] * inv8, oa[dt][4 * g + 3] * inv8);
    }
}
__device__ __forceinline__ void conv_ld8(const bf16_t* Z, size_t rowb, int ch, int thi, int tfirst, int cntv, unsigned (&vv)[8], unsigned (&gg)[8]) {
#pragma unroll
    for (int i = 0; i < 8; ++i) if (i < cntv) { const int t = tfirst + i; vv[i] = 0u; gg[i] = 0u;
        if (t >= 0 && t < thi) { const char* zp = (const char*)(Z + (rowb + t) * AB_IN + 1536); const unsigned lo = (unsigned)ch * 2u; vv[i] = *(const unsigned*)(zp + lo); gg[i] = *(const unsigned*)(zp + 2048 + lo); } }
}
__device__ __forceinline__ void conv_unit(const Args& a, LAS unsigned char* lds, int unit, int wave, int lane) {
    const bf16_t* Z = WSP(bf16_t, WS_Z); bf16_t* TMP = WSP(bf16_t, WS_CONVTMP); unsigned char* CAT = WSP(unsigned char, WS_CAT0);
    const int tid = threadIdx.x, ch = 2 * tid, b = unit >> 6, t0 = (unit & 63) * 128; const size_t rowb = (size_t)b * SEQ;
    f32x2 w[31], win[31]; const float* cwp = FIN(I_CONVW);
#pragma unroll
    for (int j = 0; j < 31; ++j) { w[j] = *(const f32x2*)(cwp + j * 1024 + ch); win[j] = (f32x2){0.f, 0.f}; }
    unsigned va[8], ga[8], vb[8], gb[8];
    conv_ld8(Z, rowb, ch, t0 + 128, t0 - 31, 8, va, ga);
#define CONV_HALF(vv, gg, i0, cntv) do { _Pragma("unroll") for (int i = 0; i < 8; ++i) if (i < (cntv)) { const int ii = (i0) + i, t = bt + ii; const bool inb = (t >= 0 && t < t0 + 128); \
            f32x2 y; y.x = inb ? bflo(vv[i]) * sigmoidf_(bflo(gg[i])) : 0.f; y.y = inb ? bfhi(vv[i]) * sigmoidf_(bfhi(gg[i])) : 0.f; win[ii] = y; \
            if (t >= t0 && t < t0 + 128) { f32x2 oq[4]; _Pragma("unroll") for (int j = 0; j < 4; ++j) oq[j] = w[j] * win[(ii + 1 + j) % 31]; \
                _Pragma("unroll") for (int j = 4; j < 31; ++j) oq[j & 3] += w[j] * win[(ii + 1 + j) % 31]; const f32x2 o = (oq[0] + oq[1]) + (oq[2] + oq[3]); \
                *(unsigned*)((char*)(TMP + (rowb + t) * 1024) + (unsigned)ch * 2u) = pk2(o.x, o.y); asm volatile("" ::: "memory"); } } } while (0)
#pragma unroll 1
    for (int g = 0; g < 6; ++g) { const int bt = t0 - 31 + 31 * g;
        conv_ld8(Z, rowb, ch, t0 + 128, bt + 8, 8, vb, gb);  CONV_HALF(va, ga, 0, 8);
        conv_ld8(Z, rowb, ch, t0 + 128, bt + 16, 8, va, ga); CONV_HALF(vb, gb, 8, 8);
        conv_ld8(Z, rowb, ch, t0 + 128, bt + 24, 7, vb, gb); CONV_HALF(va, ga, 16, 8);
        conv_ld8(Z, rowb, ch, t0 + 128, bt + 31, 8, va, ga); CONV_HALF(vb, gb, 24, 7);
    }
#undef CONV_HALF
    asm volatile("s_waitcnt vmcnt(0)" ::: "memory"); __syncthreads();
    float lg[16], lb[16], cbv[16]; { const float* pg = FIN(I_CLNG) + 16 * lane; const float* pb = FIN(I_CLNB) + 16 * lane; const float* pc = FIN(I_CONVB) + 16 * lane;
#pragma unroll
        for (int q = 0; q < 4; ++q) { const f32x4 g4 = *(const f32x4*)(pg + 4 * q), b4 = *(const f32x4*)(pb + 4 * q), c4 = *(const f32x4*)(pc + 4 * q);
#pragma unroll
            for (int i = 0; i < 4; ++i) { lg[4 * q + i] = g4[i]; lb[4 * q + i] = b4[i]; cbv[4 * q + i] = c4[i]; } } }
#pragma unroll 1
    for (int i0 = 0; i0 < 16; i0 += 4) { u32x4 ra[4], rb[4];
#pragma unroll
        for (int u = 0; u < 4; ++u) { const u32x4* p = (const u32x4*)(TMP + (rowb + t0 + wave * 16 + i0 + u) * 1024 + 16 * lane); ra[u] = p[0]; rb[u] = p[1]; }
#pragma unroll
        for (int u = 0; u < 4; ++u) { float f0[8], f1[8]; unpack8(ra[u], f0); unpack8(rb[u], f1); float s = 0.f, q = 0.f;
#pragma unroll
            for (int i = 0; i < 8; ++i) { f0[i] += cbv[i]; f1[i] += cbv[8 + i]; s += f0[i] + f1[i]; q += f0[i] * f0[i] + f1[i] * f1[i]; }
            s = wave_sum(s); q = wave_sum(q);
            const float mean = s * (1.0f / 1024.0f), var = q * (1.0f / 1024.0f) - mean * mean, rstd = __builtin_amdgcn_rsqf(fmaxf(var, 0.f) + 1e-5f);
#pragma unroll
            for (int i = 0; i < 8; ++i) { f0[i] = siluf_((f0[i] - mean) * rstd * lg[i] + lb[i]); f1[i] = siluf_((f1[i] - mean) * rstd * lg[8 + i] + lb[8 + i]); }
            u32x4 w; w.x = pk4_fp8(8.0f * f0[0], 8.0f * f0[1], 8.0f * f0[2], 8.0f * f0[3]); w.y = pk4_fp8(8.0f * f0[4], 8.0f * f0[5], 8.0f * f0[6], 8.0f * f0[7]); w.z = pk4_fp8(8.0f * f1[0], 8.0f * f1[1], 8.0f * f1[2], 8.0f * f1[3]); w.w = pk4_fp8(8.0f * f1[4], 8.0f * f1[5], 8.0f * f1[6], 8.0f * f1[7]);
            *(u32x4*)(CAT + (rowb + t0 + wave * 16 + i0 + u) * DM + 1024 + 16 * lane) = w; } }
}

__device__ __forceinline__ void prep_phase(const Args& a, int wave, int lane) {
    const bf16_t* Z = WSP(bf16_t, WS_Z); bf16_t* RKV = WSP(bf16_t, WS_RKV); bf16_t* KK = WSP(bf16_t, WS_KK); bf16_t* LIN = WSP(bf16_t, WS_LIN);
    const int gw = blockIdx.x * 8 + wave, NGW = gridDim.x * 8;
    const float *pmu = FIN(I_MU), *pkk = FIN(I_KK), *plcb = FIN(I_LCB), *plcw = FIN(I_LCW);
    static_assert(PREP_PT == 4, "prep pass = 4 consecutive tokens");
    for (int mb = gw * 4; mb < NTOK; mb += 4 * NGW) { const int t0 = mb & (SEQ - 1); const bf16_t* zr0 = Z + (size_t)mb * ZLD1; const bool hasp = t0 > 0;
#pragma unroll
        for (int i = 0; i < 6; ++i) { const int col = (lane + 64 * i) * 8;
            const f32x4 m0 = *(const f32x4*)(pmu + col), m1 = *(const f32x4*)(pmu + col + 4); f32x4 k0 = m0, k1 = m1;
            if (i == 2 || i == 3) { k0 = *(const f32x4*)(pkk + col - 1024); k1 = *(const f32x4*)(pkk + col - 1024 + 4); }
            u32x4 R[5]; R[0] = (u32x4){0u, 0u, 0u, 0u}; if (hasp) R[0] = *(const u32x4*)(zr0 - ZLD1 + col);
#pragma unroll
            for (int tt = 0; tt < 4; ++tt) R[tt + 1] = *(const u32x4*)(zr0 + (size_t)tt * ZLD1 + col);
            float p[8]; unpack8(R[0], p);
#pragma unroll
            for (int tt = 0; tt < 4; ++tt) { const int m = mb + tt; float c[8], o[8]; unpack8(R[tt + 1], c);
#pragma unroll
                for (int j = 0; j < 8; ++j) { o[j] = c[j] + (j < 4 ? m0[j] : m1[j - 4]) * (p[j] - c[j]); p[j] = c[j]; }
                *(u32x4*)(RKV + (size_t)m * 3072 + col) = pack8(o);
                if (i == 2 || i == 3) { const int kc = col - 1024; float ss = 0.f;
#pragma unroll
                    for (int j = 0; j < 8; ++j) { o[j] *= (j < 4 ? k0[j] : k1[j - 4]); ss += o[j] * o[j]; }
                    ss += __shfl_xor(ss, 1); ss += __shfl_xor(ss, 2); ss += __shfl_xor(ss, 4); const float nrm = __builtin_amdgcn_rsqf(fmaxf(ss, 1e-24f));
#pragma unroll
                    for (int j = 0; j < 8; ++j) o[j] *= nrm;
                    *(u32x4*)(KK + (size_t)m * 1024 + kc) = pack8(o); } } }
        { const int col = 3072 + lane * 8; const bool pad = (col >= 3264 && col < 3328); const int mc = pad ? 3072 : (col >= 3328 ? col - 64 : col);
          const f32x4 m0 = *(const f32x4*)(pmu + mc), m1 = *(const f32x4*)(pmu + mc + 4);
          u32x4 R[5]; R[0] = (u32x4){0u, 0u, 0u, 0u}; if (hasp) R[0] = *(const u32x4*)(zr0 - ZLD1 + col);
#pragma unroll
          for (int tt = 0; tt < 4; ++tt) R[tt + 1] = *(const u32x4*)(zr0 + (size_t)tt * ZLD1 + col);
          float p[8]; unpack8(R[0], p);
#pragma unroll
          for (int tt = 0; tt < 4; ++tt) { const int m = mb + tt; float c[8], o[8]; unpack8(R[tt + 1], c);
#pragma unroll
              for (int j = 0; j < 8; ++j) { const float v = c[j] + (j < 4 ? m0[j] : m1[j - 4]) * (p[j] - c[j]); p[j] = c[j]; o[j] = pad ? 0.f : (col < 3168 ? tanhf_(v) : (col < 3264 ? v : sigmoidf_(v))); }
              *(u32x4*)(LIN + (size_t)m * 1536 + lane * 8) = pack8(o); } }
#pragma unroll
        for (int i = 0; i < 2; ++i) { const int ch = (lane + 64 * i) * 8; const f32x4 b0 = *(const f32x4*)(plcb + ch), b1 = *(const f32x4*)(plcb + ch + 4);
            f32x4 w0[4], w1[4];
#pragma unroll
            for (int q = 0; q < 4; ++q) { w0[q] = *(const f32x4*)(plcw + q * 1024 + ch); w1[q] = *(const f32x4*)(plcw + q * 1024 + ch + 4); }
            u32x4 X[7];
#pragma unroll
            for (int r = 0; r < 7; ++r) { X[r] = (u32x4){0u, 0u, 0u, 0u}; if (t0 - 3 + r >= 0) X[r] = *(const u32x4*)(zr0 + ((long)r - 3) * ZLD1 + 3584 + ch); }
            float xf[7][8];
#pragma unroll
            for (int r = 0; r < 7; ++r) unpack8(X[r], xf[r]);
#pragma unroll
            for (int tt = 0; tt < 4; ++tt) { const int m = mb + tt; float o[8];
#pragma unroll
                for (int j = 0; j < 8; ++j) o[j] = j < 4 ? b0[j] : b1[j - 4];
#pragma unroll
                for (int q = 0; q < 4; ++q)
#pragma unroll
                    for (int j = 0; j < 8; ++j) o[j] += (j < 4 ? w0[q][j] : w1[q][j - 4]) * xf[tt + q][j];
                *(u32x4*)(LIN + (size_t)m * 1536 + 512 + ch) = pack8(o); } }
    }
}

__device__ __forceinline__ float dpp_add(float x, float y_src, int) { return x + y_src; }
#define DPP_F(x, ctrl) __builtin_bit_cast(float, __builtin_amdgcn_update_dpp(0, __builtin_bit_cast(int, (x)), (ctrl), 0xf, 0xf, true))
__device__ __forceinline__ float row16_sum(float x) { x += DPP_F(x, 0xB1); x += DPP_F(x, 0x4E); x += DPP_F(x, 0x141); x += DPP_F(x, 0x140); return x; }
constexpr int SC_T = 16, SC_REC = 384, SC_NBUF = 5, SC_BUFB = SC_T * SC_REC * 4;
__device__ __forceinline__ void ldr_issue(const Args& a, u32x4 (&ld)[6], int chunk, int lw, int lane, size_t m0, int cb) {
    const bf16_t* RKV = WSP(bf16_t, WS_RKV); const bf16_t* LD = WSP(bf16_t, WS_LD); const bf16_t* KK = WSP(bf16_t, WS_KK); const bf16_t* BB = WSP(bf16_t, WS_BB);
#pragma unroll
    for (int j = 0; j < 6; ++j) { const int q = 6 * lw + j, arr = q >> 1, s = 8 * (q & 1) + (lane >> 3), part = lane & 7; const size_t m = m0 + (size_t)chunk * SC_T + s; const bf16_t* src;
        if (arr == 0) src = RKV + m * 3072 + cb; else if (arr == 1) src = LD + m * 1024 + cb; else if (arr == 2) src = RKV + m * 3072 + 1024 + cb;
        else if (arr == 3) src = KK + m * 1024 + cb; else if (arr == 4) src = BB + m * 1024 + cb; else src = RKV + m * 3072 + 2048 + cb;
        ld[j] = *(const u32x4*)(src + 8 * part); }
}
__device__ __forceinline__ void ldr_commit(LAS float* bp, const u32x4 (&ld)[6], int lw, int lane) {
#pragma unroll
    for (int j = 0; j < 6; ++j) { const int q = 6 * lw + j, arr = q >> 1, s = 8 * (q & 1) + (lane >> 3), part = lane & 7; float f[8]; unpack8(ld[j], f);
        if (arr == 1) {
#pragma unroll
            for (int i = 0; i < 8; ++i) f[i] = fast_exp(f[i]); }
        if (arr == 3) {
#pragma unroll
            for (int i = 0; i < 8; ++i) f[i] = -f[i]; }
        LAS float* dp = bp + s * SC_REC + arr * 64 + 8 * part;
        *(LAS f32x4*)dp = (f32x4){f[0], f[1], f[2], f[3]}; *(LAS f32x4*)(dp + 4) = (f32x4){f[4], f[5], f[6], f[7]}; }
}
__device__ __forceinline__ void scan_pair_of(int beta, int& b, int& hh, int& qd) { const int p = (beta & 7) + 8 * (beta >> 5); qd = (beta >> 3) & 3; b = p >> 4; hh = p & 15; }
__device__ __forceinline__ bool scan_all_done(LAS unsigned* done, int need) {
    bool ok = true;
#pragma unroll
    for (int w = 0; w < 4; ++w) ok = ok && ((int)__hip_atomic_load(done + w, __ATOMIC_RELAXED, __HIP_MEMORY_SCOPE_WORKGROUP) >= need);
    return ok;
}
__device__ __forceinline__ void scan_loader(const Args& a, LAS unsigned char* lds, int lw, int lane) {
    LAS float* buf = (LAS float*)(lds + LDS_STAGE); LAS unsigned* ready = (LAS unsigned*)(lds + MISC_SCAN) + 2 + lw; LAS unsigned* done = (LAS unsigned*)(lds + MISC_SCAN) + 4;
    int b, hh, qd; scan_pair_of(blockIdx.x, b, hh, qd); const int cb = hh * 64; const size_t m0 = (size_t)b * SEQ;
    constexpr int NCH = SEQ / SC_T;
    u32x4 A[6], B[6];
    ldr_issue(a, A, 0, lw, lane, m0, cb);
#pragma unroll 1
    for (int c = 0; c < NCH; c += 2) {
        ldr_issue(a, B, c + 1, lw, lane, m0, cb);
        while (!scan_all_done(done, c + 1 - SC_NBUF)) __builtin_amdgcn_s_sleep(2);
        asm volatile("" ::: "memory");
        ldr_commit(buf + (c % SC_NBUF) * (SC_T * SC_REC), A, lw, lane); lds_wait();
        if (lane == 0) __hip_atomic_fetch_add(ready, 1u, __ATOMIC_RELAXED, __HIP_MEMORY_SCOPE_WORKGROUP);
        if (c + 2 < NCH) ldr_issue(a, A, c + 2, lw, lane, m0, cb);
        while (!scan_all_done(done, c + 2 - SC_NBUF)) __builtin_amdgcn_s_sleep(2);
        asm volatile("" ::: "memory");
        ldr_commit(buf + ((c + 1) % SC_NBUF) * (SC_T * SC_REC), B, lw, lane); lds_wait();
        if (lane == 0) __hip_atomic_fetch_add(ready, 1u, __ATOMIC_RELAXED, __HIP_MEMORY_SCOPE_WORKGROUP);
    }
}
__device__ __forceinline__ float dot4(const f32x4 a, const f32x4 b) { return (a.x * b.x + a.y * b.y) + (a.z * b.z + a.w * b.w); }
struct ScanOps { f32x4 r, w, k, n, b; float v; };
template <int S> __device__ __forceinline__ void scan_ld(ScanOps& o, unsigned a128, unsigned a32) {
    asm volatile("ds_read_b128 %0, %6 offset:%8\n\tds_read_b128 %1, %6 offset:%9\n\tds_read_b128 %2, %6 offset:%10\n\tds_read_b128 %3, %6 offset:%11\n\tds_read_b128 %4, %6 offset:%12\n\tds_read_b32 %5, %7 offset:%13"
                 : "=&v"(o.r), "=&v"(o.w), "=&v"(o.k), "=&v"(o.n), "=&v"(o.b), "=&v"(o.v) : "v"(a128), "v"(a32),
                   "i"(S * SC_REC * 4), "i"(S * SC_REC * 4 + 256), "i"(S * SC_REC * 4 + 512), "i"(S * SC_REC * 4 + 768), "i"(S * SC_REC * 4 + 1024), "i"(S * SC_REC * 4 + 1280) : "memory");
}
#define SCAN_WAIT(o, cnt_) asm volatile("s_waitcnt lgkmcnt(" #cnt_ ")" : "+v"((o).r), "+v"((o).w), "+v"((o).k), "+v"((o).n), "+v"((o).b), "+v"((o).v) :: "memory")
__device__ __forceinline__ void rwkv_scan(const Args& a, LAS unsigned char* lds, int wave, int lane) {
    bf16_t* Y = WSP(bf16_t, WS_Y);
    LAS unsigned* ready = (LAS unsigned*)(lds + MISC_SCAN) + 2; LAS unsigned* done = (LAS unsigned*)(lds + MISC_SCAN) + 4 + wave;
    int b, hh, qd; scan_pair_of(blockIdx.x, b, hh, qd);
    const int kl = lane & 15, rl = lane >> 4;
    constexpr int NCH = SEQ / SC_T;
    bf16_t* yrow = Y + ((size_t)(b * 16 + hh) * SEQ) * 64 + 16 * qd + 4 * wave + rl;
    const unsigned a128b = (unsigned)LDS_STAGE + 16u * (unsigned)kl, a32b = (unsigned)LDS_STAGE + 4u * (unsigned)(16 * qd + 4 * wave + rl);
    f32x4 st = {0.f, 0.f, 0.f, 0.f}, rprev = {0.f, 0.f, 0.f, 0.f};
#define SCAN_STEP(o, s) do { float sa = fma_s(st.y, (o).n.y, mul_s(st.x, (o).n.x)) + fma_s(st.w, (o).n.w, mul_s(st.z, (o).n.z)), yy = dot4(st, rprev); \
        sa += DPP_F(sa, 0xB1); yy += DPP_F(yy, 0xB1); sa += DPP_F(sa, 0x4E); yy += DPP_F(yy, 0x4E); sa += DPP_F(sa, 0x141); yy += DPP_F(yy, 0x141); sa += DPP_F(sa, 0x140); yy += DPP_F(yy, 0x140); \
        ykeep = (kl == (s)) ? yy : ykeep; st = (o).b * sa + (st * (o).w + (o).k * (o).v); rprev = (o).r; } while (0)
#define SCAN_CHUNK(c, oa, ob, oc) do { \
        if (lane == 0 && (c) > 0) __hip_atomic_fetch_add(done, 1u, __ATOMIC_RELAXED, __HIP_MEMORY_SCOPE_WORKGROUP); \
        if ((c) + 1 < NCH) { while (__hip_atomic_load(ready, __ATOMIC_RELAXED, __HIP_MEMORY_SCOPE_WORKGROUP) < (unsigned)((c) + 2) || __hip_atomic_load(ready + 1, __ATOMIC_RELAXED, __HIP_MEMORY_SCOPE_WORKGROUP) < (unsigned)((c) + 2)) __builtin_amdgcn_s_sleep(1); } \
        asm volatile("s_waitcnt lgkmcnt(0)" ::: "memory"); \
        const unsigned cur_ = (unsigned)(((c) % SC_NBUF) * SC_BUFB), nxt_ = (unsigned)((((c) + 1) % SC_NBUF) * SC_BUFB); \
        const unsigned a128 = a128b + cur_, a32 = a32b + cur_, n128 = a128b + nxt_, n32 = a32b + nxt_; float ykeep = 0.f; \
        scan_ld<2>(oc, a128, a32); SCAN_WAIT(oa, 12); SCAN_STEP(oa, 0);   scan_ld<3>(oa, a128, a32); SCAN_WAIT(ob, 12); SCAN_STEP(ob, 1);   scan_ld<4>(ob, a128, a32); SCAN_WAIT(oc, 12); SCAN_STEP(oc, 2); \
        scan_ld<5>(oc, a128, a32); SCAN_WAIT(oa, 12); SCAN_STEP(oa, 3);   scan_ld<6>(oa, a128, a32); SCAN_WAIT(ob, 12); SCAN_STEP(ob, 4);   scan_ld<7>(ob, a128, a32); SCAN_WAIT(oc, 12); SCAN_STEP(oc, 5); \
        scan_ld<8>(oc, a128, a32); SCAN_WAIT(oa, 12); SCAN_STEP(oa, 6);   scan_ld<9>(oa, a128, a32); SCAN_WAIT(ob, 12); SCAN_STEP(ob, 7);   scan_ld<10>(ob, a128, a32); SCAN_WAIT(oc, 12); SCAN_STEP(oc, 8); \
        scan_ld<11>(oc, a128, a32); SCAN_WAIT(oa, 12); SCAN_STEP(oa, 9);  scan_ld<12>(oa, a128, a32); SCAN_WAIT(ob, 12); SCAN_STEP(ob, 10); scan_ld<13>(ob, a128, a32); SCAN_WAIT(oc, 12); SCAN_STEP(oc, 11); \
        scan_ld<14>(oc, a128, a32); SCAN_WAIT(oa, 12); SCAN_STEP(oa, 12); scan_ld<15>(oa, a128, a32); SCAN_WAIT(ob, 12); SCAN_STEP(ob, 13); \
        if ((c) + 1 < NCH) { scan_ld<0>(ob, n128, n32); SCAN_WAIT(oc, 12); SCAN_STEP(oc, 14); scan_ld<1>(oc, n128, n32); SCAN_WAIT(oa, 12); SCAN_STEP(oa, 15); } \
        else { SCAN_WAIT(oc, 6); SCAN_STEP(oc, 14); SCAN_WAIT(oa, 0); SCAN_STEP(oa, 15); } \
        { const int t = (c) * SC_T + kl - 1; if (t >= 0) yrow[(size_t)t * 64] = (bf16_t)(pk2(ykeep, 0.f) & 0xffff); } \
    } while (0)
    ScanOps o0, o1, o2;
    while (__hip_atomic_load(ready, __ATOMIC_RELAXED, __HIP_MEMORY_SCOPE_WORKGROUP) < 1u || __hip_atomic_load(ready + 1, __ATOMIC_RELAXED, __HIP_MEMORY_SCOPE_WORKGROUP) < 1u) __builtin_amdgcn_s_sleep(1);
    asm volatile("s_waitcnt lgkmcnt(0)" ::: "memory");
    scan_ld<0>(o0, a128b, a32b); scan_ld<1>(o1, a128b, a32b);
#pragma unroll 1
    for (int c = 0; c + 2 < NCH; c += 3) { SCAN_CHUNK(c, o0, o1, o2); SCAN_CHUNK(c + 1, o1, o2, o0); SCAN_CHUNK(c + 2, o2, o0, o1); }
    SCAN_CHUNK(NCH - 2, o0, o1, o2); SCAN_CHUNK(NCH - 1, o1, o2, o0);
#undef SCAN_CHUNK
#undef SCAN_STEP
    if (lane == 0) __hip_atomic_fetch_add(done, 1u, __ATOMIC_RELAXED, __HIP_MEMORY_SCOPE_WORKGROUP);
    { float yy = dot4(st, rprev); yy += DPP_F(yy, 0xB1); yy += DPP_F(yy, 0x4E); yy += DPP_F(yy, 0x141); yy += DPP_F(yy, 0x140);
      if (kl == 0) yrow[(size_t)(SEQ - 1) * 64] = (bf16_t)(pk2(yy, 0.f) & 0xffff); }
}
__device__ __forceinline__ void lru_local(const Args& a, int item, int lane) {
    const int b = item >> 9, c = (item >> 3) & 63, ch = (item & 7) * 128 + lane * 2; const size_t m0 = (size_t)b * SEQ + (size_t)c * 128;
    const bf16_t* LOGA = WSP(bf16_t, WS_LOGA) + m0 * 1024 + ch; const bf16_t* UU = WSP(bf16_t, WS_U) + m0 * 1024 + ch;
    float h0 = 0.f, h1 = 0.f, l0 = 0.f, l1 = 0.f;
#pragma unroll 1
    for (int t0 = 0; t0 < 128; t0 += 16) { unsigned la[16], uv[16];
#pragma unroll
        for (int i = 0; i < 16; ++i) { la[i] = *(const unsigned*)(LOGA + (size_t)(t0 + i) * 1024); uv[i] = *(const unsigned*)(UU + (size_t)(t0 + i) * 1024); }
#pragma unroll
        for (int i = 0; i < 16; ++i) { const float x0 = bflo(la[i]), x1 = bfhi(la[i]); h0 = fast_exp(x0) * h0 + bflo(uv[i]); h1 = fast_exp(x1) * h1 + bfhi(uv[i]); l0 += x0; l1 += x1; } }
    const size_t so = ((size_t)(b * 64 + c)) * 1024 + ch;
    *(f32x2*)(WSP(float, WS_SUMA) + so) = (f32x2){fast_exp(l0), fast_exp(l1)}; *(f32x2*)(WSP(float, WS_SUMH) + so) = (f32x2){h0, h1};
}
__device__ __forceinline__ void scan_phase(const Args& a, LAS unsigned char* lds, int wave, int lane) {
    if (threadIdx.x == 0) { LAS unsigned* cw = (LAS unsigned*)(lds + MISC_SCAN); for (int i = 0; i < 8; ++i) cw[i] = 0u; }
    __syncthreads();
    if (wave < 4) { if ((int)blockIdx.x < 256) rwkv_scan(a, lds, wave, lane); }
    else if (wave >= 6) { if ((int)blockIdx.x < 256) scan_loader(a, lds, wave - 6, lane); }
    else { const int sw = blockIdx.x * 2 + (wave - 4), NSW = gridDim.x * 2;
        for (int it = sw; it < 2048; it += NSW) lru_local(a, it, lane);
        LAS float* scr = (LAS float*)(lds + LDS_STAGE + SC_NBUF * SC_BUFB + (wave - 4) * 16640);
        moe_convert_range<1>(a, 1, sw, NSW, scr, lane); }
}

__device__ __forceinline__ void post_phase(const Args& a, int wave, int lane) {
    const bf16_t* RKV = WSP(bf16_t, WS_RKV); const bf16_t* Y = WSP(bf16_t, WS_Y); const bf16_t* GG = WSP(bf16_t, WS_G); const bf16_t* Z = WSP(bf16_t, WS_Z); unsigned char* CAT = WSP(unsigned char, WS_CAT1);
    const int gw = blockIdx.x * 8 + wave, NGW = gridDim.x * 8;
    for (int item = gw; item < 2048; item += NGW) { const int b = item >> 9, c = (item >> 3) & 63, ch = (item & 7) * 128 + lane * 2; const size_t m0 = (size_t)b * SEQ + (size_t)c * 128;
        float h0 = 0.f, h1 = 0.f;
        for (int c0 = 0; c0 < c; c0 += 8) { f32x2 A[8], H[8];
#pragma unroll
            for (int u = 0; u < 8; ++u) { const int cc = (c0 + u < c) ? c0 + u : c - 1; const size_t so = ((size_t)(b * 64 + cc)) * 1024 + ch; A[u] = *(const f32x2*)(WSP(float, WS_SUMA) + so); H[u] = *(const f32x2*)(WSP(float, WS_SUMH) + so); }
#pragma unroll
            for (int u = 0; u < 8; ++u) if (c0 + u < c) { h0 = A[u].x * h0 + H[u].x; h1 = A[u].y * h1 + H[u].y; } }
        const bf16_t* LOGA = WSP(bf16_t, WS_LOGA) + m0 * 1024 + ch; const bf16_t* UU = WSP(bf16_t, WS_U) + m0 * 1024 + ch; const bf16_t* GB = Z + m0 * ZLD1 + 4608 + ch; unsigned char* O = CAT + m0 * DM + 1024 + ch;
#pragma unroll 1
        for (int t0 = 0; t0 < 128; t0 += 16) { unsigned la[16], uv[16], gb[16];
#pragma unroll
            for (int i = 0; i < 16; ++i) { la[i] = *(const unsigned*)(LOGA + (size_t)(t0 + i) * 1024); uv[i] = *(const unsigned*)(UU + (size_t)(t0 + i) * 1024); gb[i] = *(const unsigned*)(GB + (size_t)(t0 + i) * ZLD1); }
#pragma unroll
            for (int i = 0; i < 16; ++i) { h0 = fast_exp(bflo(la[i])) * h0 + bflo(uv[i]); h1 = fast_exp(bfhi(la[i])) * h1 + bfhi(uv[i]);
                *(unsigned short*)(O + (size_t)(t0 + i) * DM) = (unsigned short)(pk4_fp8(8.0f * h0 * gelu_tanh(bflo(gb[i])), 8.0f * h1 * gelu_tanh(bfhi(gb[i])), 0.f, 0.f) & 0xffffu); } } }
    const int hd = lane >> 2, seg = (lane & 3) * 16, ch = hd * 64 + seg;
    float lg0[8], lg1[8], lb0[8], lb1[8], rk0[8], rk1[8]; const float *plg = FIN(I_LNXG), *plb = FIN(I_LNXB), *prk = FIN(I_RK);
#pragma unroll
    for (int j = 0; j < 8; ++j) { lg0[j] = plg[ch + j]; lg1[j] = plg[ch + 8 + j]; lb0[j] = plb[ch + j]; lb1[j] = plb[ch + 8 + j]; rk0[j] = prk[ch + j]; rk1[j] = prk[ch + 8 + j]; }
    for (int m = gw; m < NTOK; m += NGW) { const int b = m >> 13, t = m & (SEQ - 1);
        float y0[8], y1[8], r0[8], r1[8], k0[8], k1[8], v0[8], v1[8], g0[8], g1[8];
        { const u32x4* p = (const u32x4*)(Y + (((size_t)(b * 16 + hd) * SEQ) + t) * 64 + seg); unpack8(p[0], y0); unpack8(p[1], y1); }
        { const u32x4* p = (const u32x4*)(RKV + (size_t)m * 3072 + ch); unpack8(p[0], r0); unpack8(p[1], r1); }
        { const u32x4* p = (const u32x4*)(RKV + (size_t)m * 3072 + 1024 + ch); unpack8(p[0], k0); unpack8(p[1], k1); }
        { const u32x4* p = (const u32x4*)(RKV + (size_t)m * 3072 + 2048 + ch); unpack8(p[0], v0); unpack8(p[1], v1); }
        { const u32x4* p = (const u32x4*)(GG + (size_t)m * 1024 + ch); unpack8(p[0], g0); unpack8(p[1], g1); }
        float s = 0.f, dot = 0.f;
#pragma unroll
        for (int j = 0; j < 8; ++j) { s += y0[j] + y1[j]; dot += r0[j] * k0[j] * rk0[j] + r1[j] * k1[j] * rk1[j]; }
        s += __shfl_xor(s, 1); s += __shfl_xor(s, 2); dot += __shfl_xor(dot, 1); dot += __shfl_xor(dot, 2);
        const float mu = s * (1.0f / 64.0f); float q = 0.f;
#pragma unroll
        for (int j = 0; j < 8; ++j) { const float d0 = y0[j] - mu, d1 = y1[j] - mu; q += d0 * d0 + d1 * d1; }
        q += __shfl_xor(q, 1); q += __shfl_xor(q, 2); const float rstd = __builtin_amdgcn_rsqf(q * (1.0f / 64.0f) + 64e-5f);
        float o0[8], o1[8];
#pragma unroll
        for (int j = 0; j < 8; ++j) { o0[j] = 8.0f * ((y0[j] - mu) * rstd * lg0[j] + lb0[j] + dot * v0[j]) * g0[j]; o1[j] = 8.0f * ((y1[j] - mu) * rstd * lg1[j] + lb1[j] + dot * v1[j]) * g1[j]; }
        u32x4 w; w.x = pk4_fp8(o0[0], o0[1], o0[2], o0[3]); w.y = pk4_fp8(o0[4], o0[5], o0[6], o0[7]); w.z = pk4_fp8(o1[0], o1[1], o1[2], o1[3]); w.w = pk4_fp8(o1[4], o1[5], o1[6], o1[7]);
        *(u32x4*)(CAT + (size_t)m * DM + ch) = w;
    }
}
#ifndef MK_PER_PHASE
#define MK_PER_PHASE 0
#endif
constexpr int N_PHASES = 21;
__global__ void __launch_bounds__(512, 2) fwd(Args a) {
    extern __shared__ __attribute__((aligned(16))) unsigned char lds_raw[];
    LAS unsigned char* lds = (LAS unsigned char*)lds_raw;
    const int tid = threadIdx.x, wave = __builtin_amdgcn_readfirstlane(tid >> 6);
#define lane (lane_now())
    if (tid < 64) ((LAS unsigned*)lds)[tid] = 0u;
    __syncthreads();
    unsigned* barw = WSP(unsigned, WS_CTL) + a.li * XCD_BAR_WORDS;
    XcdBarrier bar; bar.bar = barw; bar.x = 0; bar.st = nullptr;
    if (!MK_PER_PHASE) bar = xcd_barrier_post(barw, (volatile LAS unsigned*)(lds + MISC_XB));
    const int lo = a.ph_lo, hi = a.ph_hi;
#ifndef PHMASK
#define PHMASK 0x1fffff
#endif
#define IN(k) (((PHMASK >> (k)) & 1) && lo <= (k) && (k) < hi)
#ifndef REPMASK
#define REPMASK 0
#endif
#define NREP(k) (((REPMASK >> (k)) & 1) ? 2 : 1)
#define SEAM(k) do { if ((k) + 1 < hi) { if (!MK_PER_PHASE) xcd_barrier(bar); } } while (0)
    const int G = gridDim.x, c = blockIdx.x;
    float* MOD = WSP(float, WS_CTL + CTL_MOD);
    LAS unsigned char* stage = lds + LDS_STAGE;

    if (IN(0)) {  p0_prologue(a, lds, wave, lane);  SEAM(0); }
    if (IN(1)) {  norm_phase<0, false, true>(a, wave, lane, FIN(I_X), FIN(I_NMIX), MOD, 0, nullptr);  SEAM(1); }
    if (IN(2)) {  g8::DenseSched S{NTOK / 256, AB_IN / 256, G, c, (const char*)WSP(unsigned char, WS_H), (const char*)WSP(unsigned char, WS_WIN0), (size_t)256 * DM, (size_t)256 * DM};
        EpiBf16T<true> E{WSP(bf16_t, WS_Z), AB_IN}; g8::gemm_phase(stage, DM / 2, DM / 2, DM / 2, S, E);
        SEAM(2);
        }
    if (IN(3)) {  for (int u = c; u < 1024; u += G) attn_unit(a, lds, u, wave, lane);
        for (int u = c; u < 256; u += G) conv_unit(a, lds, u, wave, lane);  SEAM(3); }
    if (IN(4)) {  g8::DenseSched S{NTOK / 256, DM / 256, G, c, (const char*)WSP(unsigned char, WS_CAT0), (const char*)WSP(unsigned char, WS_WOUT0), (size_t)256 * DM, (size_t)256 * DM};
        EpiResid<false> E{FIN(I_X), (bf16_t*)a.out, MOD + 2 * DM}; g8::gemm_phase(stage, DM / 2, DM / 2, DM / 2, S, E);  SEAM(4); }
    if (IN(5)) { route_norm_phase(a, lds, wave, lane, (const bf16_t*)a.out, FIN(I_NFFN), MOD, 3, 0); SEAM(5); }
    if (IN(6)) { moe_assign_phase(a, lds, wave, lane, 0); SEAM(6); }
    if (IN(7)) {  moe_tile_starts(a, lds, 0); const LAS int* ts = (const LAS int*)(lds + MISC_TSTART);
        MoeSchedT<true> S{__builtin_amdgcn_readfirstlane(ts[16]), 8, G, c, ts, (const char*)WSP(unsigned char, WS_H), (const char*)WSP(unsigned char, WS_MW13), (size_t)256 * DM, (size_t)256 * DM, (size_t)2048 * 2048, WSP(int, WS_ROWTOK)};
        EpiHid E{WSP(unsigned char, WS_HID)}; g8::gemm_phase(stage, DM / 2, DM / 2, DM / 2, S, E);  SEAM(7); }
    if (IN(8)) {  moe_tile_starts(a, lds, 0); const LAS int* ts = (const LAS int*)(lds + MISC_TSTART);
        MoeSchedT<false> S{__builtin_amdgcn_readfirstlane(ts[16]), 8, G, c, ts, (const char*)WSP(unsigned char, WS_HID), (const char*)WSP(unsigned char, WS_MW2), (size_t)256 * DEXP, (size_t)256 * DEXP, (size_t)2048 * 1024, nullptr};
        EpiY8 E{WSP(unsigned char, WS_YB), DM}; g8::gemm_phase(stage, DEXP / 2, DEXP / 2, DEXP / 2, S, E);  SEAM(8); }
    if (IN(9)) { norm_phase<1, true, true>(a, wave, lane, a.out, FIN(I_NMIX) + DM, MOD + 4 * 12288, 0, MOD + 5 * DM); SEAM(9); }
    if (IN(10)) {  g8::DenseSched S{NTOK / 256, ZLD1 / 256, G, c, (const char*)WSP(unsigned char, WS_H), (const char*)WSP(unsigned char, WS_WIN1), (size_t)256 * DM, (size_t)256 * DM};
        EpiBf16T<true> E{WSP(bf16_t, WS_Z), ZLD1}; g8::gemm_phase(stage, DM / 2, DM / 2, DM / 2, S, E);  SEAM(10); }
    if (IN(11)) {  prep_phase(a, wave, lane);  SEAM(11); }
    if (IN(12)) { MultiSched S{G, c, (const char*)WSP(bf16_t, WS_LIN), (const char*)a.ws};
        EpiL1 E{WSP(bf16_t, WS_LD), WSP(bf16_t, WS_RKV), WSP(bf16_t, WS_KK), WSP(bf16_t, WS_BB), WSP(bf16_t, WS_G), WSP(bf16_t, WS_LOGA), WSP(bf16_t, WS_U), WSP(bf16_t, WS_LIN),
                FIN(I_W0), FIN(I_A0), FIN(I_KA), FIN(I_LBA), FIN(I_LBX), FIN(I_LAM)};
        g8::gemm_phase(stage, 1536, 256, 256, S, E); SEAM(12); }
    if (IN(13)) {  scan_phase(a, lds, wave, lane);  SEAM(13); }
    if (IN(14)) {  post_phase(a, wave, lane);  SEAM(14); }
    if (IN(15)) { g8::DenseSched S{NTOK / 256, DM / 256, G, c, (const char*)WSP(unsigned char, WS_CAT1), (const char*)WSP(unsigned char, WS_WOUT1), (size_t)256 * DM, (size_t)256 * DM};
        EpiResid<true> E{a.out, WSP(bf16_t, WS_X3), MOD + 4 * 12288 + 2 * DM}; g8::gemm_phase(stage, DM / 2, DM / 2, DM / 2, S, E); SEAM(15); }
    if (IN(16)) { route_norm_phase(a, lds, wave, lane, WSP(bf16_t, WS_X3), FIN(I_NFFN) + DM, MOD + 4 * 12288, 3, 1); SEAM(16); }
    if (IN(17)) { moe_assign_phase(a, lds, wave, lane, 1); SEAM(17); }
    if (IN(18)) {  moe_tile_starts(a, lds, 1); const LAS int* ts = (const LAS int*)(lds + MISC_TSTART);
        MoeSchedT<true> S{__builtin_amdgcn_readfirstlane(ts[16]), 8, G, c, ts, (const char*)WSP(unsigned char, WS_H), (const char*)WSP(unsigned char, WS_MW13), (size_t)256 * DM, (size_t)256 * DM, (size_t)2048 * 2048, WSP(int, WS_ROWTOK)};
        EpiHid E{WSP(unsigned char, WS_HID)}; g8::gemm_phase(stage, DM / 2, DM / 2, DM / 2, S, E);  SEAM(18); }
    if (IN(19)) {  moe_tile_starts(a, lds, 1); const LAS int* ts = (const LAS int*)(lds + MISC_TSTART);
        MoeSchedT<false> S{__builtin_amdgcn_readfirstlane(ts[16]), 8, G, c, ts, (const char*)WSP(unsigned char, WS_HID), (const char*)WSP(unsigned char, WS_MW2), (size_t)256 * DEXP, (size_t)256 * DEXP, (size_t)2048 * 1024, nullptr};
        EpiY8 E{WSP(unsigned char, WS_YB), DM}; g8::gemm_phase(stage, DEXP / 2, DEXP / 2, DEXP / 2, S, E);  SEAM(19); }
    if (IN(20)) { norm_phase<5, true>(a, wave, lane, WSP(bf16_t, WS_X3), FIN(I_FNORM), MOD, 0, MOD + 4 * 12288 + 5 * DM); }
#undef IN
#undef SEAM
#undef lane
}

extern "C" void kernel_launch(void* const* d_in, const int* in_sizes, int n_in, void* d_out, int out_size, void* d_ws, size_t ws_size, hipStream_t stream) {
    static int grid = 0;
    if (grid == 0) {
        if (n_in != 40 || in_sizes[0] != NTOK * DM || out_size != NTOK * DM || ws_size < WS_END) { fprintf(stderr, "kernel_launch: unexpected shapes (n_in %d, ws %zu < %zu)\n", n_in, ws_size, (size_t)WS_END); grid = -1; return; }
        int dev = 0, cus = 0, per_cu = 0;
        if (hipGetDevice(&dev) != hipSuccess || hipDeviceGetAttribute(&cus, hipDeviceAttributeMultiprocessorCount, dev) != hipSuccess) { grid = -1; return; }
        if (hipFuncSetAttribute((const void*)fwd, hipFuncAttributeMaxDynamicSharedMemorySize, LDS_BYTES) != hipSuccess) { fprintf(stderr, "kernel_launch: hipFuncSetAttribute failed\n"); grid = -1; return; }
        if (hipOccupancyMaxActiveBlocksPerMultiprocessor(&per_cu, (const void*)fwd, 512, LDS_BYTES) != hipSuccess || per_cu < 1) fprintf(stderr, "kernel_launch: occupancy query reports %d\n", per_cu);
        (void)hipGetLastError();
        grid = cus;
        if (grid != 256) fprintf(stderr, "kernel_launch: %d CUs (built for 256)\n", grid);
    }
    if (grid < 0) return;
    (void)hipMemsetAsync((char*)d_ws + WS_CTL, 0, CTL_ZERO_BYTES, stream);
    Args a{};
    for (int i = 0; i < 40; ++i) a.in[i] = d_in[i];
    a.out = (float*)d_out; a.ws = (unsigned char*)d_ws;
#if MK_PER_PHASE
    for (int k = 0; k < N_PHASES; ++k) { a.ph_lo = k; a.ph_hi = k + 1; hipLaunchKernelGGL(fwd, dim3(grid), dim3(512), LDS_BYTES, stream, a); }
#else
#ifdef PROBE_K
    a.ph_lo = 0; a.ph_hi = PROBE_K; a.li = 1; hipLaunchKernelGGL(fwd, dim3(grid), dim3(512), LDS_BYTES, stream, a);
#endif
    a.ph_lo = 0; a.ph_hi = N_PHASES; a.li = 0; hipLaunchKernelGGL(fwd, dim3(grid), dim3(512), LDS_BYTES, stream, a);
#endif
}
```

```cpp
#include <hip/hip_runtime.h>
#include <stdint.h>
#include <stdio.h>

#define LAS __attribute__((address_space(3)))
typedef unsigned short bf16_t;
typedef short bf16x8 __attribute__((ext_vector_type(8)));
typedef float f32x2 __attribute__((ext_vector_type(2)));
typedef float f32x4 __attribute__((ext_vector_type(4)));
typedef float f32x16 __attribute__((ext_vector_type(16)));
typedef unsigned u32x2 __attribute__((ext_vector_type(2)));
typedef unsigned u32x4 __attribute__((ext_vector_type(4)));

constexpr int DM = 2048, NB = 4, SEQ = 8192, NTOK = NB * SEQ;
constexpr int PREP_PT = 4;
constexpr int AB_IN = 3584, CD_IN = 5568, ZLD1 = 5632;
constexpr int NEXP = 16, DEXP = 1024;
constexpr int MOE_ROWS = NTOK * 2 + NEXP * 256;
constexpr float LOG2E = 1.4426950408889634f;

constexpr size_t MiB = (size_t)1 << 20;
constexpr size_t WS_CTL = 0, CTL_ZERO_BYTES = 2 * MiB;
constexpr size_t CTL_CNT = 57344;
constexpr size_t CTL_CUR = 57344 + 256;
constexpr size_t CTL_MOD = 65536;
constexpr size_t WS_BWA = 2 * MiB, WS_BG = 3 * MiB, WS_BLRU = 3 * MiB + 512 * 1024;
constexpr size_t WS_ROWTOK = 4 * MiB + 512 * 1024;
constexpr size_t WS_ROPE = 5 * MiB;
constexpr size_t WS_TOKE = 13 * MiB, WS_TOKG = WS_TOKE + 256 * 1024, WS_TOKP = WS_TOKG + 256 * 1024;
constexpr size_t WS_SUMA = 14 * MiB, WS_SUMH = 15 * MiB;
constexpr size_t WS_WIN0 = 16 * MiB, WS_WIN1 = 30 * MiB, WS_WOUT0 = 52 * MiB, WS_WOUT1 = 60 * MiB;
constexpr size_t WS_MW13 = 68 * MiB, WS_MW2 = 196 * MiB;
constexpr size_t WS_H = 260 * MiB;
constexpr size_t WS_KK = WS_H, WS_BB = WS_H + 64 * MiB, WS_CAT1 = WS_H;
constexpr size_t WS_Z = 388 * MiB;
constexpr size_t WS_YB = WS_Z;
constexpr size_t WS_X3 = WS_Z + 160 * MiB;
constexpr size_t WS_R = 740 * MiB;
constexpr size_t WS_CAT0 = WS_R, WS_HID = WS_R, WS_RKV = WS_R;
constexpr size_t WS_S = 932 * MiB;
constexpr size_t WS_LIN = WS_S, WS_Y = WS_S, WS_LD = WS_S + 96 * MiB, WS_G = WS_LD + 64 * MiB, WS_LOGA = WS_G + 64 * MiB, WS_U = WS_LOGA + 64 * MiB;
constexpr size_t WS_XS = WS_S;
constexpr size_t WS_CONVTMP = WS_S;
constexpr size_t WS_END = WS_U + 64 * MiB;
static_assert(WS_XS + (size_t)MOE_ROWS * 2048 * 2 <= WS_END, "XS fits");
static_assert(WS_HID + (size_t)MOE_ROWS * 1024 * 2 <= WS_S, "HID fits");
static_assert(WS_YB + (size_t)MOE_ROWS * 2048 * 2 <= WS_R, "YB fits");

constexpr int LDS_MISC = 4096;
constexpr int LDS_STAGE = 4096;
constexpr int LDS_BYTES = 4096 + 5 * 24576 + 2 * 16640;
constexpr int MISC_XB = 0;
constexpr int MISC_HIST = 64;
constexpr int MISC_TSTART = 128;
constexpr int MISC_BBASE = 256;
constexpr int MISC_SCAN = 320;

__device__ __forceinline__ float bflo(unsigned w) { return __uint_as_float(w << 16); }
__device__ __forceinline__ float bfhi(unsigned w) { return __uint_as_float(w & 0xffff0000u); }
__device__ __forceinline__ unsigned pk2(float lo, float hi) { unsigned r; asm volatile("v_cvt_pk_bf16_f32 %0, %1, %2" : "=v"(r) : "v"(lo), "v"(hi)); return r; }
__device__ __forceinline__ float wave_sum(float v) {
#pragma unroll
    for (int o = 32; o >= 1; o >>= 1) v += __shfl_xor(v, o);
    return v;
}
__device__ __forceinline__ float fast_exp(float x) { return __builtin_amdgcn_exp2f(x * LOG2E); }
__device__ __forceinline__ float fast_rcp(float x) { return __builtin_amdgcn_rcpf(x); }
__device__ __forceinline__ float sigmoidf_(float x) { return fast_rcp(1.0f + fast_exp(-x)); }
__device__ __forceinline__ float siluf_(float x) { return x * sigmoidf_(x); }
__device__ __forceinline__ float tanhf_(float x) { const float e = fast_exp(2.0f * x); return 1.0f - 2.0f * fast_rcp(e + 1.0f); }
__device__ __forceinline__ float softplusf_(float x) { return fmaxf(x, 0.0f) + __builtin_amdgcn_logf(1.0f + fast_exp(-fabsf(x))) * 0.6931471805599453f; }
__device__ __forceinline__ float gelu_tanh(float x) { const float u = 0.7978845608028654f * (x + 0.044715f * x * x * x); return 0.5f * x * (1.0f + tanhf_(u)); }
__device__ __forceinline__ float fma_s(float a, float b, float c) { float d; asm("v_fma_f32 %0, %1, %2, %3" : "=v"(d) : "v"(a), "v"(b), "v"(c)); return d; }
__device__ __forceinline__ float mul_s(float a, float b) { float d; asm("v_mul_f32 %0, %1, %2" : "=v"(d) : "v"(a), "v"(b)); return d; }
__device__ __forceinline__ int lane_now() { int t = threadIdx.x; asm volatile("" : "+v"(t)); return t & 63; }
__device__ __forceinline__ void lds_wait() { asm volatile("s_waitcnt lgkmcnt(0)" ::: "memory"); }
__device__ __forceinline__ void unpack8(const u32x4 w, float (&f)[8]) {
    f[0] = bflo(w.x); f[1] = bfhi(w.x); f[2] = bflo(w.y); f[3] = bfhi(w.y); f[4] = bflo(w.z); f[5] = bfhi(w.z); f[6] = bflo(w.w); f[7] = bfhi(w.w);
}
__device__ __forceinline__ u32x4 pack8(const float (&f)[8]) { u32x4 w; w.x = pk2(f[0], f[1]); w.y = pk2(f[2], f[3]); w.z = pk2(f[4], f[5]); w.w = pk2(f[6], f[7]); return w; }

#define XB_TMO      128
#define XB_XCNT(j)  (256  + 64 * (j))
#define XB_XSUB(j)  (1280 + 64 * (j))
#define XB_XGEN(j)  (2304 + 64 * (j))
#define XB_TOP      3328
#define XB_TOPGEN   3392
#define XCD_BAR_WORDS 3456
#define XB_SPIN_CAP (1u << 18)

__device__ __forceinline__ unsigned xb_ld(unsigned* p)              { return __hip_atomic_load(p, __ATOMIC_RELAXED, __HIP_MEMORY_SCOPE_AGENT); }
__device__ __forceinline__ unsigned xb_add(unsigned* p, unsigned v) { return __hip_atomic_fetch_add(p, v, __ATOMIC_RELAXED, __HIP_MEMORY_SCOPE_AGENT); }
__device__ __forceinline__ unsigned xb_xcc_id() { return (unsigned)__builtin_amdgcn_s_getreg((3 << 11) | 20) & 0xFu; }
#define XB_SPIN(cond, bar) do { unsigned _sp = 0; while (cond) { __builtin_amdgcn_s_sleep(1); \
    if ((++_sp & 255u) == 0u) { if (xb_ld(&(bar)[XB_TMO])) break; if (_sp > XB_SPIN_CAP) { atomicAdd(&(bar)[XB_TMO], 1u); break; } } } } while (0)

struct XcdBarrier {
    unsigned* bar; unsigned x;
    volatile LAS unsigned* st;
};
__device__ __forceinline__ XcdBarrier xcd_barrier_post(unsigned* bar, volatile LAS unsigned* st) {
    XcdBarrier b; b.bar = bar; b.x = xb_xcc_id(); b.st = st;
    if (threadIdx.x == 0) (void)xb_add(&bar[XB_XCNT(b.x)], 1u);
    return b;
}
__device__ __forceinline__ void xcd_barrier_complete(unsigned* bar, unsigned x, unsigned& nloc, unsigned& nx) {
    const unsigned G = gridDim.x * gridDim.y * gridDim.z;
    unsigned sum, cnt, mine, sp = 0u;
    for (;;) {
        sum = 0u; cnt = 0u; mine = 0u;
#pragma unroll
        for (unsigned j = 0; j < 16; ++j) { const unsigned c = xb_ld(&bar[XB_XCNT(j)]); sum += c; cnt += (c > 0u) ? 1u : 0u; mine = (j == x) ? c : mine; }
        if (sum == G) break;
        __builtin_amdgcn_s_sleep(1);
        if ((++sp & 255u) == 0u) { if (xb_ld(&bar[XB_TMO])) break; if (sp > XB_SPIN_CAP) { atomicAdd(&bar[XB_TMO], 1u); break; } }
    }
    nloc = mine > 0u ? mine : 1u; nx = cnt > 0u ? cnt : 1u;
}
__device__ __forceinline__ void xcd_barrier(const XcdBarrier& b) {
    asm volatile("s_waitcnt vmcnt(0)" ::: "memory");
    __syncthreads();
    if (threadIdx.x == 0) {
        unsigned* bar = b.bar;
        __builtin_amdgcn_s_waitcnt(0);
        unsigned nloc = b.st[0], nx = b.st[1];
        if (nloc == 0u) { xcd_barrier_complete(bar, b.x, nloc, nx); b.st[0] = nloc; b.st[1] = nx; }
        const unsigned old = xb_add(&bar[XB_XSUB(b.x)], 1u);
        const unsigned gen = old / nloc;
        if (old + 1u == (gen + 1u) * nloc) {
            __builtin_amdgcn_fence(__ATOMIC_RELEASE, "agent");
            asm volatile("s_waitcnt vmcnt(0)" ::: "memory");
            const unsigned og = xb_add(&bar[XB_TOP], 1u);
            const unsigned tg = og / nx;
            if (og + 1u == (tg + 1u) * nx) xb_add(&bar[XB_TOPGEN], 1u);
            else XB_SPIN(xb_ld(&bar[XB_TOPGEN]) == tg, bar);
            __builtin_amdgcn_fence(__ATOMIC_ACQUIRE, "agent");
            xb_add(&bar[XB_XGEN(b.x)], 1u);
            asm volatile("s_waitcnt vmcnt(0)" ::: "memory");
        } else {
            XB_SPIN(xb_ld(&bar[XB_XGEN(b.x)]) == gen, bar);
            __builtin_amdgcn_fence(__ATOMIC_ACQUIRE, "agent");
            asm volatile("s_waitcnt vmcnt(0)" ::: "memory");
        }
    }
    __syncthreads();
}

namespace g8 {
constexpr int BM = 256, BK = 64, HALF = 128, HTB = HALF * BK * 2, STAGE_BYTES = 8 * HTB, NXCD = 8, WGM = 8;
__device__ __forceinline__ int lds_byte(int r, int c) { const int st = (r >> 4) * 2 + (c >> 5), rr = r & 15, cc = c & 31, ob = rr * 64 + cc * 2; return st * 1024 + (ob ^ (((ob >> 9) & 1) << 5)); }
__device__ __forceinline__ void stage_rc(int b, int& R, int& C) { const int st = b / 1024, sb = b % 1024, swz = sb ^ (((sb >> 9) & 1) << 5); R = (st >> 1) * 16 + swz / 64; C = (st & 1) * 32 + (swz % 64) / 2; }
__device__ __forceinline__ int perm32(int rho) { const int n = rho >> 4, i = rho & 15; return 8 * (i >> 2) + 4 * n + (i & 3); }

struct Unit { int pm, pn, kind, e; };
typedef int v8i __attribute__((ext_vector_type(8)));
typedef int v4i __attribute__((ext_vector_type(4)));
__device__ __forceinline__ v8i cat8(const bf16x8 lo, const bf16x8 hi) { const v4i a = __builtin_bit_cast(v4i, lo), b = __builtin_bit_cast(v4i, hi); return __builtin_shufflevector(a, b, 0, 1, 2, 3, 4, 5, 6, 7); }
__device__ __forceinline__ bool tile_of(long L, int nM, int nN, int& pm, int& pn) {
    const int nwg = nM * nN; if (L >= nwg) return false;
    int wgid = (int)L; { const int q = nwg / NXCD, r = nwg % NXCD, xcd = wgid % NXCD, off = wgid / NXCD; wgid = (xcd < r ? xcd * (q + 1) : r * (q + 1) + (xcd - r) * q) + off; }
    const int nig = WGM * nN, gid = wgid / nig, fm = gid * WGM, gsz = (nM - fm) < WGM ? (nM - fm) : WGM;
    pm = fm + ((wgid % nig) % gsz); pn = (wgid % nig) / gsz; return true;
}
struct DenseSched {
    static constexpr bool GATHER = false;
    int nM, nN, G, c; const char* A; const char* B; size_t tA, tB;
    __device__ __forceinline__ bool next(int i, Unit& u) const { u.kind = 0; u.e = 0; return tile_of((long)i * G + c, nM, nN, u.pm, u.pn); }
    __device__ __forceinline__ const char* abase(const Unit& u) const { return A + (size_t)u.pm * tA; }
    __device__ __forceinline__ const char* bbase(const Unit& u) const { return B + (size_t)u.pn * tB; }
};

template <class Epi, class Sched>
__device__ __forceinline__ void gemm_phase(LAS unsigned char* lds, const int lda, const int ldb, const int K, const Sched& S, const Epi& E) {
    const int tid = threadIdx.x, wid = __builtin_amdgcn_readfirstlane(tid >> 6), lane = tid & 63, wr = wid >> 2, wc = wid & 3, fr = lane & 15, fq = lane >> 4;
    const int nt = K / BK;
    unsigned voffA[2], voffB[2];
#pragma unroll
    for (int i = 0; i < 2; ++i) { int R, C; stage_rc(tid * 16 + i * 8192, R, C); const int Rb = Epi::PERM ? ((R & ~31) + perm32(R & 31)) : R;
        voffA[i] = (unsigned)(R * lda + C) * 2u; voffB[i] = (unsigned)(Rb * ldb + C) * 2u; }
    const size_t kstep = (size_t)(BK * 2);
    const size_t hstepA = (size_t)HALF * lda * 2, hstepB = (size_t)HALF * ldb * 2;
    const unsigned ldsw = (unsigned)wid * 1024u;
    const unsigned ldsaddr = (unsigned)(unsigned long)lds + ldsw;
    const int aoff = lds_byte(wr * 64 + fr, fq * 8), boff = lds_byte(wc * 32 + fr, fq * 8);
#define PG8_SA(b, h) (((b) * 2 + (h)) * HTB)
#define PG8_SB(b, h) ((4 + (b) * 2 + (h)) * HTB)
#define PG8_STAGE(bufoff, gbase, voff) do { _Pragma("unroll") for (int _i = 0; _i < 2; ++_i) { unsigned _keep; \
        asm volatile("s_mov_b32 %0, m0\n\ts_mov_b32 m0, %3\n\ts_nop 0\n\tglobal_load_lds_dwordx4 %1, %2\n\ts_mov_b32 m0, %0" : "=&s"(_keep) : "v"((voff)[_i]), "s"((const char*)(gbase)), "s"(ldsaddr + (unsigned)((bufoff) + _i * 8192)) : "memory"); } } while (0)
#define PG8_STAGE_A(bufoff, h, kb, U) do { if constexpr (Sched::GATHER) { const unsigned _vo[2] = {(U) ? vN[h][0] : vC[h][0], (U) ? vN[h][1] : vC[h][1]}; PG8_STAGE(bufoff, gA + (kb), _vo); } \
        else PG8_STAGE(bufoff, ((U) ? nA : cA) + (kb) + (size_t)(h) * hstepA, voffA); } while (0)
#define PG8_LDA(dst, b, h) do { _Pragma("unroll") for (int m = 0; m < 4; ++m) _Pragma("unroll") for (int k = 0; k < 2; ++k) dst[m][k] = *(const LAS bf16x8*)(lds + PG8_SA(b, h) + aoff + m * 2048 + k * 1024); } while (0)
#define PG8_LDB(dst, b, h) do { _Pragma("unroll") for (int n = 0; n < 2; ++n) _Pragma("unroll") for (int k = 0; k < 2; ++k) dst[n][k] = *(const LAS bf16x8*)(lds + PG8_SB(b, h) + boff + n * 2048 + k * 1024); } while (0)
#define PG8_MMA(ai, bj, At, Bt) do { __builtin_amdgcn_s_setprio(1); _Pragma("unroll") for (int m = 0; m < 4; ++m) _Pragma("unroll") for (int n = 0; n < 2; ++n) _Pragma("unroll") for (int k = 0; k < 2; ++k) \
        acc[ai][bj][m][n] = __builtin_amdgcn_mfma_f32_16x16x32_bf16(Bt[n][k], At[m][k], acc[ai][bj][m][n], 0, 0, 0); __builtin_amdgcn_s_setprio(0); } while (0)
#define PG8_LDA8(dst, b, h) do { _Pragma("unroll") for (int m = 0; m < 4; ++m) dst[m] = cat8(*(const LAS bf16x8*)(lds + PG8_SA(b, h) + aoff + m * 2048), *(const LAS bf16x8*)(lds + PG8_SA(b, h) + aoff + m * 2048 + 1024)); } while (0)
#define PG8_LDB8(dst, b, h) do { _Pragma("unroll") for (int n = 0; n < 2; ++n) dst[n] = cat8(*(const LAS bf16x8*)(lds + PG8_SB(b, h) + boff + n * 2048), *(const LAS bf16x8*)(lds + PG8_SB(b, h) + boff + n * 2048 + 1024)); } while (0)
#define PG8_MMA8(ai, bj, At, Bt) do { __builtin_amdgcn_s_setprio(1); _Pragma("unroll") for (int m = 0; m < 4; ++m) _Pragma("unroll") for (int n = 0; n < 2; ++n) \
        asm volatile("v_mfma_scale_f32_16x16x128_f8f6f4 %0, %1, %2, %0, %3, %4 op_sel_hi:[0,0,0]" : "+v"(acc[ai][bj][m][n]) : "v"(Bt[n]), "v"(At[m]), "v"(scB), "v"(scA)); __builtin_amdgcn_s_setprio(0); } while (0)
#define PG8_WAIT_V(n) asm volatile("s_waitcnt vmcnt(" #n ")" ::: "memory")
#define PG8_WAIT_L(n) asm volatile("s_waitcnt lgkmcnt(" #n ")" ::: "memory")
#define PG8_BAR __builtin_amdgcn_s_barrier()
#define PG8_SCHED __builtin_amdgcn_sched_barrier(0)
    Unit cur, nxt; int ui = 0;
    if (!S.next(0, cur)) return;
    f32x4 acc[2][2][4][2];
#pragma unroll
    for (int a = 0; a < 2; ++a)
#pragma unroll
        for (int b = 0; b < 2; ++b)
#pragma unroll
            for (int m = 0; m < 4; ++m)
#pragma unroll
                for (int n = 0; n < 2; ++n) acc[a][b][m][n] = (f32x4){0.f, 0.f, 0.f, 0.f};
    bf16x8 At[4][2], B0[2][2], B1[2][2]; v8i At8[4], B08[2], B18[2]; const int scA = Epi::SC_A, scB = Epi::SC_B;
    const char* cA = S.abase(cur); const char* cB = S.bbase(cur); const char* nA = cA;
    unsigned vC[2][2] = {{0u, 0u}, {0u, 0u}}, vN[2][2] = {{0u, 0u}, {0u, 0u}}; int rawN[2][2] = {{0, 0}, {0, 0}}; const char* gA = cA; int rrow[2] = {0, 0}; unsigned ccol[2] = {0u, 0u};
    if constexpr (Sched::GATHER) { gA = S.gbase();
#pragma unroll
        for (int i = 0; i < 2; ++i) { int R, C; stage_rc(tid * 16 + i * 8192, R, C); rrow[i] = R; ccol[i] = (unsigned)C * 2u; }
#pragma unroll
        for (int h = 0; h < 2; ++h)
#pragma unroll
            for (int i = 0; i < 2; ++i) asm volatile("global_load_dword %0, %1, off" : "=&v"(rawN[h][i]) : "v"(S.rowtab + cur.pm * 256 + h * 128 + rrow[i]) : "memory");
        asm volatile("s_waitcnt vmcnt(0)" : "+v"(rawN[0][0]), "+v"(rawN[0][1]), "+v"(rawN[1][0]), "+v"(rawN[1][1]) :: "memory");
#pragma unroll
        for (int h = 0; h < 2; ++h)
#pragma unroll
            for (int i = 0; i < 2; ++i) { vC[h][i] = (unsigned)rawN[h][i] * (unsigned)(lda * 2) + ccol[i]; vN[h][i] = vC[h][i]; } }
    PG8_STAGE(PG8_SB(0, 0), cB, voffB); PG8_STAGE(PG8_SB(0, 1), cB + hstepB, voffB); PG8_STAGE_A(PG8_SA(0, 0), 0, 0, false); PG8_STAGE_A(PG8_SA(0, 1), 1, 0, false);
    if (wr == 1) PG8_BAR;
    PG8_WAIT_V(2); PG8_BAR;
    PG8_STAGE(PG8_SB(1, 0), cB + kstep, voffB); PG8_STAGE_A(PG8_SA(1, 0), 0, kstep, false); PG8_STAGE(PG8_SB(1, 1), cB + hstepB + kstep, voffB);
    PG8_WAIT_V(6); PG8_BAR;
    for (;;) {
        const bool has_next = S.next(ui + 1, nxt);
        nA = has_next ? S.abase(nxt) : cA; const char* nB = has_next ? S.bbase(nxt) : cB;
#pragma unroll 1
        for (int t = 0; t < nt; t += 2) {
            const bool last = (t == nt - 2);
            const size_t ka1 = (size_t)(t + 1) * kstep, ka2 = last ? (size_t)0 : (size_t)(t + 2) * kstep, ka3 = ka2 + kstep;
            const char* b2 = last ? nB : cB + (size_t)(t + 2) * kstep; const char* b3 = b2 + kstep;
            if constexpr (Sched::GATHER) {
                if (t == 0 && has_next) {
#pragma unroll
                    for (int h = 0; h < 2; ++h)
#pragma unroll
                        for (int i = 0; i < 2; ++i) asm volatile("global_load_dword %0, %1, off" : "=&v"(rawN[h][i]) : "v"(S.rowtab + nxt.pm * 256 + h * 128 + rrow[i]) : "memory"); }
                if (last && has_next) { if (nt < 6) asm volatile("s_waitcnt vmcnt(0)" ::: "memory");
                    asm volatile("" : "+v"(rawN[0][0]), "+v"(rawN[0][1]), "+v"(rawN[1][0]), "+v"(rawN[1][1]));
#pragma unroll
                    for (int h = 0; h < 2; ++h)
#pragma unroll
                        for (int i = 0; i < 2; ++i) vN[h][i] = (unsigned)rawN[h][i] * (unsigned)(lda * 2) + ccol[i]; }
            }
            if constexpr (Epi::F8) {
            PG8_LDB8(B08, 0, 0); PG8_LDB8(B18, 0, 1); PG8_SCHED; PG8_LDA8(At8, 0, 0); PG8_STAGE_A(PG8_SA(1, 1), 1, ka1, false);
            PG8_WAIT_V(8); PG8_WAIT_L(0); PG8_BAR; PG8_MMA8(0, 0, At8, B08); PG8_MMA8(0, 1, At8, B18); PG8_BAR; PG8_SCHED;
            PG8_LDA8(At8, 0, 1); PG8_STAGE(PG8_SB(0, 0), b2, voffB); PG8_STAGE(PG8_SB(0, 1), b2 + hstepB, voffB); PG8_STAGE_A(PG8_SA(0, 0), 0, ka2, last);
            PG8_WAIT_V(8); PG8_WAIT_L(0); PG8_BAR; PG8_MMA8(1, 0, At8, B08); PG8_MMA8(1, 1, At8, B18); PG8_BAR; PG8_SCHED;
            PG8_LDB8(B08, 1, 0); PG8_LDB8(B18, 1, 1); PG8_SCHED; PG8_LDA8(At8, 1, 0); PG8_STAGE_A(PG8_SA(0, 1), 1, ka2, last);
            PG8_WAIT_V(8); PG8_WAIT_L(0); PG8_BAR; PG8_MMA8(0, 0, At8, B08); PG8_MMA8(0, 1, At8, B18); PG8_BAR; PG8_SCHED;
            PG8_LDA8(At8, 1, 1); PG8_STAGE(PG8_SB(1, 0), b3, voffB); PG8_STAGE(PG8_SB(1, 1), b3 + hstepB, voffB); PG8_STAGE_A(PG8_SA(1, 0), 0, ka3, last);
            PG8_WAIT_V(8); PG8_WAIT_L(0); PG8_BAR; PG8_MMA8(1, 0, At8, B08); PG8_MMA8(1, 1, At8, B18); PG8_BAR; PG8_SCHED;
            } else {
            PG8_LDB(B0, 0, 0); PG8_LDB(B1, 0, 1); PG8_SCHED; PG8_LDA(At, 0, 0); PG8_STAGE_A(PG8_SA(1, 1), 1, ka1, false);
            PG8_WAIT_V(8); PG8_WAIT_L(0); PG8_BAR; PG8_MMA(0, 0, At, B0); PG8_MMA(0, 1, At, B1); PG8_BAR; PG8_SCHED;
            PG8_LDA(At, 0, 1); PG8_STAGE(PG8_SB(0, 0), b2, voffB); PG8_STAGE(PG8_SB(0, 1), b2 + hstepB, voffB); PG8_STAGE_A(PG8_SA(0, 0), 0, ka2, last);
            PG8_WAIT_V(8); PG8_WAIT_L(0); PG8_BAR; PG8_MMA(1, 0, At, B0); PG8_MMA(1, 1, At, B1); PG8_BAR; PG8_SCHED;
            PG8_LDB(B0, 1, 0); PG8_LDB(B1, 1, 1); PG8_SCHED; PG8_LDA(At, 1, 0); PG8_STAGE_A(PG8_SA(0, 1), 1, ka2, last);
            PG8_WAIT_V(8); PG8_WAIT_L(0); PG8_BAR; PG8_MMA(0, 0, At, B0); PG8_MMA(0, 1, At, B1); PG8_BAR; PG8_SCHED;
            PG8_LDA(At, 1, 1); PG8_STAGE(PG8_SB(1, 0), b3, voffB); PG8_STAGE(PG8_SB(1, 1), b3 + hstepB, voffB); PG8_STAGE_A(PG8_SA(1, 0), 0, ka3, last);
            PG8_WAIT_V(8); PG8_WAIT_L(0); PG8_BAR; PG8_MMA(1, 0, At, B0); PG8_MMA(1, 1, At, B1); PG8_BAR; PG8_SCHED;
            }
        }
        if (wr == 0) PG8_BAR;
        if constexpr (Epi::F8) {
            asm volatile("s_nop 15\n\ts_nop 15\n\ts_nop 15" : "+v"(acc[1][1][0][0]), "+v"(acc[1][1][0][1]), "+v"(acc[1][1][1][0]), "+v"(acc[1][1][1][1]), "+v"(acc[1][1][2][0]), "+v"(acc[1][1][2][1]), "+v"(acc[1][1][3][0]), "+v"(acc[1][1][3][1]) :: "memory");
            asm volatile("" : "+v"(acc[1][0][0][0]), "+v"(acc[1][0][0][1]), "+v"(acc[1][0][1][0]), "+v"(acc[1][0][1][1]), "+v"(acc[1][0][2][0]), "+v"(acc[1][0][2][1]), "+v"(acc[1][0][3][0]), "+v"(acc[1][0][3][1])); }
        E(acc, cur, wr, wc, fr, fq);
        if (!has_next) break;
#pragma unroll
        for (int a = 0; a < 2; ++a)
#pragma unroll
            for (int b = 0; b < 2; ++b)
#pragma unroll
                for (int m = 0; m < 4; ++m)
#pragma unroll
                    for (int n = 0; n < 2; ++n) acc[a][b][m][n] = (f32x4){0.f, 0.f, 0.f, 0.f};
        cur = nxt; cA = nA; cB = nB; ++ui;
        if constexpr (Sched::GATHER) {
#pragma unroll
            for (int h = 0; h < 2; ++h)
#pragma unroll
                for (int i = 0; i < 2; ++i) vC[h][i] = vN[h][i]; }
        if (wr == 1) PG8_BAR;
    }
    PG8_WAIT_V(0);
    PG8_BAR;
#undef PG8_SA
#undef PG8_SB
#undef PG8_STAGE
#undef PG8_STAGE_A
#undef PG8_LDA
#undef PG8_LDB
#undef PG8_MMA
#undef PG8_MMA8
#undef PG8_LDA8
#undef PG8_LDB8
#undef PG8_WAIT_V
#undef PG8_WAIT_L
#undef PG8_BAR
#undef PG8_SCHED
}
}
struct Args { const void* in[40]; float* out; unsigned char* ws; int ph_lo, ph_hi, li, pad; };
enum { I_X = 0, I_C, I_POS, I_RW, I_RB, I_ADAW, I_ADAB, I_NMIX, I_NFFN, I_W1, I_W3, I_W2, I_ABWIN, I_SINKS, I_CONVW, I_CONVB, I_CLNG, I_CLNB, I_ABWOUT,
       I_CDWIN, I_MU, I_W0, I_LW2, I_A0, I_LA2, I_LG2, I_KK, I_KA, I_RK, I_LNXG, I_LNXB, I_LCW, I_LCB, I_LWA, I_LBA, I_LWX, I_LBX, I_LAM, I_CDWOUT, I_FNORM };
template <int K> __device__ __forceinline__ const float* kin() { const float* p; asm volatile("s_load_dwordx2 %0, %1, %2\n\ts_waitcnt lgkmcnt(0)" : "=s"(p) : "s"(__builtin_amdgcn_kernarg_segment_ptr()), "n"(K * 8) : "memory"); return p; }
#define FIN(k) (kin<k>())
#define WSP(T, off) ((T*)(a.ws + (off)))

__device__ __forceinline__ float clamp448(float v) { return __builtin_amdgcn_fmed3f(v, -448.0f, 448.0f); }
__device__ __forceinline__ unsigned pk4_fp8(float a, float b, float c, float d) { int w = 0; w = __builtin_amdgcn_cvt_pk_fp8_f32(clamp448(a), clamp448(b), w, false); w = __builtin_amdgcn_cvt_pk_fp8_f32(clamp448(c), clamp448(d), w, true); return (unsigned)w; }
__device__ __forceinline__ void transpose_tile(const float* src, int Nsrc, int k0, int n0, bf16_t* dst, int ldk, int drow0, LAS float* scr, int lane) {
#pragma unroll
    for (int i = 0; i < 16; ++i) { const int k = i * 4 + (lane >> 4), n4 = (lane & 15) * 4;
        const f32x4 v = *(const f32x4*)(src + (size_t)(k0 + k) * Nsrc + n0 + n4);
        LAS float* p = scr + k * 65 + n4; p[0] = v.x; p[1] = v.y; p[2] = v.z; p[3] = v.w; }
    lds_wait();
#pragma unroll
    for (int i = 0; i < 8; ++i) { const int n = i * 8 + (lane >> 3), k8 = (lane & 7) * 8; const LAS float* p = scr + k8 * 65 + n;
        u32x4 o; o.x = pk2(p[0], p[65]); o.y = pk2(p[2 * 65], p[3 * 65]); o.z = pk2(p[4 * 65], p[5 * 65]); o.w = pk2(p[6 * 65], p[7 * 65]);
        *(u32x4*)(dst + (size_t)(drow0 + n) * ldk + k0 + k8) = o; }
    lds_wait();
}
__device__ __forceinline__ void transpose_tile8(const float* src, int Nsrc, int k0, int n0, unsigned char* dst, int ldk, int drow0, float sc, LAS float* scr, int lane) {
#pragma unroll
    for (int i = 0; i < 16; ++i) { const int k = i * 4 + (lane >> 4), n4 = (lane & 15) * 4;
        const f32x4 v = *(const f32x4*)(src + (size_t)(k0 + k) * Nsrc + n0 + n4);
        LAS float* p = scr + k * 65 + n4; p[0] = v.x; p[1] = v.y; p[2] = v.z; p[3] = v.w; }
    lds_wait();
#pragma unroll
    for (int i = 0; i < 8; ++i) { const int n = i * 8 + (lane >> 3), k8 = (lane & 7) * 8; const LAS float* p = scr + k8 * 65 + n;
        u32x2 o; o.x = pk4_fp8(p[0] * sc, p[65] * sc, p[2 * 65] * sc, p[3 * 65] * sc); o.y = pk4_fp8(p[4 * 65] * sc, p[5 * 65] * sc, p[6 * 65] * sc, p[7 * 65] * sc);
        *(u32x2*)(dst + (size_t)(drow0 + n) * ldk + k0 + k8) = o; }
    lds_wait();
}
constexpr int T_MOE1 = 16 * 32 * 16;
struct MoeTile { const float* src; unsigned char* dst; int Nsrc, ldk; };
__device__ __forceinline__ void moe_tile_of(const Args& a, int layer, int it, MoeTile& d) {
    const int which = it / T_MOE1, r = it % T_MOE1, e = r / 512, q = r % 512;
    if (which < 2) {
        const int kt = q % 32, n0 = (q / 32) * 64;
        d.src = (which == 0 ? FIN(I_W1) : FIN(I_W3)) + (size_t)(layer * 16 + e) * 2048 * 1024 + (size_t)(kt * 64) * 1024 + n0; d.Nsrc = 1024;
        d.dst = WSP(unsigned char, WS_MW13) + (size_t)e * 2048 * 2048 + (size_t)((n0 >> 7) * 256 + which * 128 + (n0 & 127)) * 2048 + kt * 64; d.ldk = 2048;
    } else {
        const int kt = q % 16, n0 = (q / 16) * 64;
        d.src = FIN(I_W2) + (size_t)(layer * 16 + e) * 1024 * 2048 + (size_t)(kt * 64) * 2048 + n0; d.Nsrc = 2048;
        d.dst = WSP(unsigned char, WS_MW2) + (size_t)e * 2048 * 1024 + (size_t)n0 * 1024 + kt * 64; d.ldk = 1024;
    }
}
__device__ __forceinline__ void moe_tile_load(const MoeTile& d, f32x4 (&r)[16], int lane) {
#pragma unroll
    for (int i = 0; i < 16; ++i) r[i] = __builtin_nontemporal_load((const f32x4*)(d.src + (size_t)(i * 4 + (lane >> 4)) * d.Nsrc + (lane & 15) * 4));
}
__device__ __forceinline__ void moe_tile_finish(const MoeTile& d, const f32x4 (&r)[16], LAS float* scr, int lane) {
#pragma unroll
    for (int i = 0; i < 16; ++i) { LAS float* p = scr + (i * 4 + (lane >> 4)) * 65 + (lane & 15) * 4; p[0] = r[i].x; p[1] = r[i].y; p[2] = r[i].z; p[3] = r[i].w; }
    lds_wait();
#pragma unroll
    for (int i = 0; i < 8; ++i) { const int n = i * 8 + (lane >> 3), k8 = (lane & 7) * 8; const LAS float* p = scr + k8 * 65 + n;
        u32x2 o; o.x = pk4_fp8(p[0] * 64.0f, p[65] * 64.0f, p[2 * 65] * 64.0f, p[3 * 65] * 64.0f); o.y = pk4_fp8(p[4 * 65] * 64.0f, p[5 * 65] * 64.0f, p[6 * 65] * 64.0f, p[7 * 65] * 64.0f);
        *(u32x2*)(d.dst + (size_t)n * d.ldk + k8) = o; }
    lds_wait();
}
template <int THROTTLE = 0>
__device__ __forceinline__ void moe_convert_range(const Args& a, int layer, int first, int stride, LAS float* scr, int lane) {
    constexpr int LIM = 3 * T_MOE1; int it = first; if (it >= LIM) return;
    MoeTile dA, dB; f32x4 rA[16], rB[16];
    moe_tile_of(a, layer, it, dA); moe_tile_load(dA, rA, lane);
    for (;;) {
        it += stride; const bool hb = it < LIM; if (hb) { moe_tile_of(a, layer, it, dB); moe_tile_load(dB, rB, lane); }
        moe_tile_finish(dA, rA, scr, lane); if (THROTTLE) { __builtin_amdgcn_s_sleep(127); __builtin_amdgcn_s_sleep(127); } if (!hb) break;
        it += stride; const bool ha = it < LIM; if (ha) { moe_tile_of(a, layer, it, dA); moe_tile_load(dA, rA, lane); }
        moe_tile_finish(dB, rB, scr, lane); if (THROTTLE) { __builtin_amdgcn_s_sleep(127); __builtin_amdgcn_s_sleep(127); } if (!ha) break;
    }
}
__device__ __forceinline__ void p0_prologue(const Args& a, LAS unsigned char* lds, int wave, int lane) {
    LAS float* scr = (LAS float*)(lds + LDS_STAGE + wave * 16640);
    const int gw = blockIdx.x * 8 + wave, NGW = gridDim.x * 8;
    if (blockIdx.x == 0 && threadIdx.x < 128) WSP(unsigned, WS_CTL + CTL_CNT)[threadIdx.x] = 0u;
    constexpr int T_WIN0 = 32 * 56, T_WOUT = 32 * 32, T_WIN1 = 32 * 87, T_ADA = 2 * 768, T_SMALL = (2048 + 1024 + 2048) * 256 / 512, T_ROPE = NTOK * 32 / 512, T_PAD = 256;
    constexpr int E0 = 3 * T_MOE1, E1 = E0 + T_ADA, E2 = E1 + T_WIN0, E3 = E2 + T_WOUT, E4 = E3 + T_WIN1, E5 = E4 + T_WOUT, E6 = E5 + T_SMALL, E7 = E6 + T_ROPE, E8 = E7 + T_PAD;
    moe_convert_range(a, 0, gw, NGW, scr, lane);
    for (int it = E0 + gw; it < E8; it += NGW) {
        if (it < E1) {
            const int r = it - E0, layer = r / 768, cg = r % 768, col = cg * 16 + (lane & 3) * 4, kr = lane >> 2;
            const float* W = FIN(I_ADAW) + (size_t)layer * 2048 * 12288 + col; const float* cv = FIN(I_C);
            f32x4 s0 = {0.f, 0.f, 0.f, 0.f}, s1 = s0, s2 = s0, s3 = s0;
            for (int k0 = kr; k0 < 2048; k0 += 128) { f32x4 w[8]; float c0[8], c1[8], c2[8], c3[8];
#pragma unroll
                for (int u = 0; u < 8; ++u) { const int k = k0 + 16 * u; w[u] = *(const f32x4*)(W + (size_t)k * 12288); c0[u] = cv[k]; c1[u] = cv[2048 + k]; c2[u] = cv[4096 + k]; c3[u] = cv[6144 + k]; }
#pragma unroll
                for (int u = 0; u < 8; ++u) { s0 += w[u] * siluf_(c0[u]); s1 += w[u] * siluf_(c1[u]); s2 += w[u] * siluf_(c2[u]); s3 += w[u] * siluf_(c3[u]); } }
#pragma unroll
            for (int o = 4; o <= 32; o <<= 1) {
#pragma unroll
                for (int j = 0; j < 4; ++j) { s0[j] += __shfl_xor(s0[j], o); s1[j] += __shfl_xor(s1[j], o); s2[j] += __shfl_xor(s2[j], o); s3[j] += __shfl_xor(s3[j], o); } }
            if (lane < 4) { const f32x4 bv = *(const f32x4*)(FIN(I_ADAB) + layer * 12288 + col); float* M = WSP(float, WS_CTL + CTL_MOD) + (size_t)layer * 4 * 12288 + col;
                *(f32x4*)M = s0 + bv; *(f32x4*)(M + 12288) = s1 + bv; *(f32x4*)(M + 2 * 12288) = s2 + bv; *(f32x4*)(M + 3 * 12288) = s3 + bv; }
            continue; }
        if (it < E2) { const int r = it - E1; transpose_tile8(FIN(I_ABWIN), AB_IN, (r % 32) * 64, (r / 32) * 64, WSP(unsigned char, WS_WIN0), 2048, (r / 32) * 64, 64.0f, scr, lane); continue; }
        if (it < E3) { const int r = it - E2; transpose_tile8(FIN(I_ABWOUT), 2048, (r % 32) * 64, (r / 32) * 64, WSP(unsigned char, WS_WOUT0), 2048, (r / 32) * 64, 64.0f, scr, lane); continue; }
        if (it < E4) { const int r = it - E3, n0 = (r / 32) * 64;
            transpose_tile8(FIN(I_CDWIN), CD_IN, (r % 32) * 64, n0, WSP(unsigned char, WS_WIN1), 2048, n0 >= 3264 ? n0 + 64 : n0, 64.0f, scr, lane); continue; }
        if (it < E5) { const int r = it - E4; transpose_tile8(FIN(I_CDWOUT), 2048, (r % 32) * 64, (r / 32) * 64, WSP(unsigned char, WS_WOUT1), 2048, (r / 32) * 64, 64.0f, scr, lane); continue; }
        if (it < E6) {
            const int r = (it - E5) * 64 + lane, row = r >> 5, k8 = (r & 31) * 8; float f[8]; bf16_t* dst;
            const float *lw2 = FIN(I_LW2), *la2 = FIN(I_LA2), *lg2 = FIN(I_LG2), *lwa = FIN(I_LWA), *lwx = FIN(I_LWX);
            if (row < 2048) {
                dst = WSP(bf16_t, WS_BWA) + (size_t)row * 256 + k8;
#pragma unroll
                for (int j = 0; j < 8; ++j) { const int k = k8 + j; f[j] = row < 1024 ? (k < 96 ? lw2[k * 1024 + row] : 0.f) : ((k >= 96 && k < 192) ? la2[(k - 96) * 1024 + row - 1024] : 0.f); }
            } else if (row < 3072) {
                const int n = row - 2048; dst = WSP(bf16_t, WS_BG) + (size_t)n * 256 + k8;
#pragma unroll
                for (int j = 0; j < 8; ++j) f[j] = lg2[(k8 + j) * 1024 + n];
            } else {
                const int rr = row - 3072, pn = rr >> 8, half = (rr >> 7) & 1, cc = rr & 127, g = 2 * pn + (cc >> 6), jj = cc & 63, kb = 4 * (pn >> 1);
                dst = WSP(bf16_t, WS_BLRU) + (size_t)rr * 256 + k8; const float* Wg = (half ? lwx : lwa) + (size_t)g * 4096;
#pragma unroll
                for (int j = 0; j < 8; ++j) { const int k = k8 + j; f[j] = ((k >> 6) + kb == g) ? Wg[(k & 63) * 64 + jj] : 0.f; }
            }
            *(u32x4*)dst = pack8(f); continue; }
        if (it < E7) {
            const int r = (it - E6) * 512 + lane * 8, tok = r >> 5, i0 = r & 31; const double pos = (double)((const int*)FIN(I_POS))[tok];
            double fr_ = 1.0; for (int i = 0; i < i0; ++i) fr_ *= 0.74989420933245582730;
            f32x2* dst = WSP(f32x2, WS_ROPE) + (size_t)tok * 32 + i0;
#pragma unroll
            for (int j = 0; j < 8; ++j) { const double rev = pos * fr_ * 0.15915494309189533577; const float fr32 = (float)(rev - __builtin_rint(rev));
                dst[j] = (f32x2){__builtin_amdgcn_cosf(fr32), __builtin_amdgcn_sinf(fr32)}; fr_ *= 0.74989420933245582730; }
            continue; }
        { const int r = (it - E7) * 64 + lane; if (r < 8192) *(u32x4*)(WSP(unsigned char, WS_WIN1) + (size_t)3264 * 2048 + (size_t)r * 16) = (u32x4){0u, 0u, 0u, 0u}; }
    }
}

template <int MODE, bool SRC16, bool H8 = false>
__device__ __forceinline__ void norm_phase(const Args& a, int wave, int lane, const void* xsrc, const float* gn, const float* modv  , int ishift  ,
                                           const float* gatef  ) {
    constexpr bool COMB = MODE & 1, FINAL = (MODE & 4) != 0;
    const int gw = blockIdx.x * 8 + wave, WPB = gridDim.x * 2, b = gw / WPB, wb = gw - b * WPB;
    f32x4 PA[8], PB[8], GF[8];
    { const f32x4* gp = (const f32x4*)gn + lane;
      if (FINAL) {
#pragma unroll
          for (int j = 0; j < 8; ++j) { PA[j] = gp[64 * j]; PB[j] = (f32x4){0.f, 0.f, 0.f, 0.f}; } }
      else { const f32x4* shp = (const f32x4*)(modv + (size_t)b * 12288 + ishift * DM) + lane; const f32x4* scp = (const f32x4*)(modv + (size_t)b * 12288 + (ishift + 1) * DM) + lane;
#pragma unroll
          for (int j = 0; j < 8; ++j) { PA[j] = gp[64 * j] * (scp[64 * j] + 1.0f); PB[j] = shp[64 * j]; } }
      if (COMB) { const f32x4* gf = (const f32x4*)(gatef + (size_t)b * 12288) + lane;
#pragma unroll
          for (int j = 0; j < 8; ++j) GF[j] = gf[64 * j]; } }
    for (int i = wb; i < SEQ; i += WPB) { const int m = b * SEQ + i;
        f32x4 v[8];
        if (SRC16) { const u32x2* xr = (const u32x2*)((const bf16_t*)xsrc + (size_t)m * DM) + lane;
#pragma unroll
            for (int j = 0; j < 8; ++j) { const u32x2 w = xr[64 * j]; v[j] = (f32x4){bflo(w.x), bfhi(w.x), bflo(w.y), bfhi(w.y)}; } }
        else { const f32x4* xr = (const f32x4*)((const float*)xsrc + (size_t)m * DM) + lane;
#pragma unroll
            for (int j = 0; j < 8; ++j) v[j] = xr[64 * j]; }
        if (COMB) {
            const int2 pp = WSP(int2, WS_TOKP)[m]; const f32x2 gg = WSP(f32x2, WS_TOKG)[m];
            const unsigned* y0 = (const unsigned*)(WSP(unsigned char, WS_YB) + (size_t)pp.x * DM) + lane; const unsigned* y1 = (const unsigned*)(WSP(unsigned char, WS_YB) + (size_t)pp.y * DM) + lane;
            u32x2* xo = (u32x2*)((bf16_t*)xsrc + (size_t)m * DM) + lane; const float g0s = gg.x * (1.0f / 32.0f), g1s = gg.y * (1.0f / 32.0f);
#pragma unroll
            for (int j = 0; j < 8; ++j) { const unsigned p0 = y0[64 * j], p1 = y1[64 * j];
                const f32x2 a0 = __builtin_amdgcn_cvt_pk_f32_fp8((int)p0, false), a1 = __builtin_amdgcn_cvt_pk_f32_fp8((int)p0, true), b0 = __builtin_amdgcn_cvt_pk_f32_fp8((int)p1, false), b1 = __builtin_amdgcn_cvt_pk_f32_fp8((int)p1, true);
                f32x4 yv; yv.x = g0s * a0.x + g1s * b0.x; yv.y = g0s * a0.y + g1s * b0.y; yv.z = g0s * a1.x + g1s * b1.x; yv.w = g0s * a1.y + g1s * b1.y;
                v[j] += GF[j] * yv; if (!FINAL) { u32x2 o; o.x = pk2(v[j].x, v[j].y); o.y = pk2(v[j].z, v[j].w); xo[64 * j] = o; } } }
        float ss = 0.f;
#pragma unroll
        for (int j = 0; j < 8; ++j) ss += (v[j].x * v[j].x + v[j].y * v[j].y) + (v[j].z * v[j].z + v[j].w * v[j].w);
        const float rs = __builtin_amdgcn_rsqf(wave_sum(ss) * (1.0f / DM) + 1e-6f);
        if (FINAL) { f32x4* xo = (f32x4*)(a.out + (size_t)m * DM) + lane;
#pragma unroll
            for (int j = 0; j < 8; ++j) xo[64 * j] = v[j] * rs * PA[j];
            continue; }
#pragma unroll
        for (int j = 0; j < 8; ++j) { const f32x4 h = (v[j] * rs) * PA[j] + PB[j];
            if (H8) ((unsigned*)(WSP(unsigned char, WS_H) + (size_t)m * DM))[lane + 64 * j] = pk4_fp8(h.x, h.y, h.z, h.w);
            else { u32x2 o; o.x = pk2(h.x, h.y); o.y = pk2(h.z, h.w); ((u32x2*)(WSP(bf16_t, WS_H) + (size_t)m * DM) + lane)[64 * j] = o; } }
    }
}

__device__ __forceinline__ void route_pick(const Args& a, const float (&L)[16], int m, bool writer, const float* rbias, LAS unsigned* hist) {
    float mx = L[0];
#pragma unroll
    for (int e = 1; e < 16; ++e) mx = fmaxf(mx, L[e]);
    float P[16], sum = 0.f;
#pragma unroll
    for (int e = 0; e < 16; ++e) { P[e] = __expf(L[e] - mx); sum += P[e]; }
    const float inv = 1.0f / sum; float sel[16];
#pragma unroll
    for (int e = 0; e < 16; ++e) { P[e] *= inv; sel[e] = P[e] + rbias[e]; }
    int gbest = 0; float gsc = -1e30f;
#pragma unroll
    for (int g = 0; g < 4; ++g) { const float x0 = sel[4 * g], x1 = sel[4 * g + 1], x2 = sel[4 * g + 2], x3 = sel[4 * g + 3];
        const float m1 = fmaxf(x0, x1), n1 = fminf(x0, x1), m2 = fmaxf(x2, x3), n2 = fminf(x2, x3);
        const float sc = fmaxf(m1, m2) + fmaxf(fminf(m1, m2), fmaxf(n1, n2)); if (sc > gsc) { gsc = sc; gbest = g; } }
    float s4[4], p4[4];
#pragma unroll
    for (int i = 0; i < 4; ++i) { s4[i] = 0.f; p4[i] = 0.f; }
#pragma unroll
    for (int g = 0; g < 4; ++g)
#pragma unroll
        for (int i = 0; i < 4; ++i) { s4[i] = (g == gbest) ? sel[4 * g + i] : s4[i]; p4[i] = (g == gbest) ? P[4 * g + i] : p4[i]; }
    int i1 = 0; float b1 = s4[0];
#pragma unroll
    for (int i = 1; i < 4; ++i) if (s4[i] > b1) { b1 = s4[i]; i1 = i; }
    int i2 = -1; float b2 = -1e30f;
#pragma unroll
    for (int i = 0; i < 4; ++i) if (i != i1 && s4[i] > b2) { b2 = s4[i]; i2 = i; }
    float g1 = 0.f, g2 = 0.f;
#pragma unroll
    for (int i = 0; i < 4; ++i) { g1 = (i == i1) ? p4[i] : g1; g2 = (i == i2) ? p4[i] : g2; }
    const float gi = 1.0f / (g1 + g2);
    if (writer) { const int e1 = gbest * 4 + i1, e2 = gbest * 4 + i2;
        WSP(int2, WS_TOKE)[m] = make_int2(e1, e2); WSP(f32x2, WS_TOKG)[m] = (f32x2){g1 * gi, g2 * gi};
        __hip_atomic_fetch_add(&hist[e1], 1u, __ATOMIC_RELAXED, __HIP_MEMORY_SCOPE_WORKGROUP); __hip_atomic_fetch_add(&hist[e2], 1u, __ATOMIC_RELAXED, __HIP_MEMORY_SCOPE_WORKGROUP); }
}
__device__ __forceinline__ void route_norm_phase(const Args& a, LAS unsigned char* lds, int wave, int lane, const bf16_t* xsrc, const float* gn, const float* modv  , int ishift, int cnt_layer) {
    LAS float* rwB = (LAS float*)(lds + LDS_STAGE); LAS float* PAl = (LAS float*)(lds + LDS_STAGE + 131072); LAS float* PBl = PAl + 2048;
    LAS unsigned* hist = (LAS unsigned*)(lds + MISC_HIST);
    const float* rbias = FIN(I_RB);
    const int BPB = gridDim.x >> 2, b = blockIdx.x / BPB, bi = blockIdx.x - b * BPB;
    if (b >= NB) return;
    { const float* rw = FIN(I_RW);
      for (int idx = threadIdx.x; idx < 2048 * 16; idx += 512) { const int k = idx >> 4, n = idx & 15; rwB[((((k >> 6) * 4 + ((k >> 2) & 3)) * 64 + ((k >> 4) & 3) * 16 + n) << 2) + (k & 3)] = rw[idx]; }
      const float* sh = modv + (size_t)b * 12288 + ishift * DM;
      for (int idx = threadIdx.x; idx < DM; idx += 512) { PAl[idx] = gn[idx] * (sh[DM + idx] + 1.0f); PBl[idx] = sh[idx]; }
      if (threadIdx.x < 16) hist[threadIdx.x] = 0u;
      __syncthreads(); }
    const int ti = lane & 15, kq = lane >> 4;
    for (int g = bi * 8 + wave; g < SEQ / 16; g += BPB * 8) {
        const int m0 = b * SEQ + g * 16; const bf16_t* xr = xsrc + (size_t)(m0 + ti) * DM + 16 * kq;
        float ss = 0.f;
#pragma unroll 1
        for (int c0 = 0; c0 < 32; c0 += 8) { u32x4 r[8][2];
#pragma unroll
            for (int u = 0; u < 8; ++u) { const u32x4* p = (const u32x4*)(xr + 64 * (c0 + u)); r[u][0] = p[0]; r[u][1] = p[1]; }
#pragma unroll
            for (int u = 0; u < 8; ++u) { float f[8]; unpack8(r[u][0], f);
#pragma unroll
                for (int j = 0; j < 8; ++j) ss += f[j] * f[j];
                unpack8(r[u][1], f);
#pragma unroll
                for (int j = 0; j < 8; ++j) ss += f[j] * f[j]; } }
        ss += __shfl_xor(ss, 16); ss += __shfl_xor(ss, 32);
        const float rs = __builtin_amdgcn_rsqf(ss * (1.0f / DM) + 1e-6f);
        f32x4 acc = {0.f, 0.f, 0.f, 0.f};
        unsigned char* hrow = WSP(unsigned char, WS_H) + (size_t)(m0 + ti) * DM + 16 * kq;
#pragma unroll 1
        for (int c0 = 0; c0 < 32; c0 += 8) { u32x4 r[8][2];
#pragma unroll
            for (int u = 0; u < 8; ++u) { const u32x4* p = (const u32x4*)(xr + 64 * (c0 + u)); r[u][0] = p[0]; r[u][1] = p[1]; }
#pragma unroll
            for (int u = 0; u < 8; ++u) { const int c = c0 + u; float x0[8], x1[8], h[16]; unpack8(r[u][0], x0); unpack8(r[u][1], x1);
#pragma unroll
                for (int q4 = 0; q4 < 4; ++q4) { const f32x4 pa = *(const LAS f32x4*)(PAl + 64 * c + 16 * kq + 4 * q4), pb = *(const LAS f32x4*)(PBl + 64 * c + 16 * kq + 4 * q4);
#pragma unroll
                    for (int s = 0; s < 4; ++s) { const float xv = q4 < 2 ? x0[4 * q4 + s] : x1[4 * (q4 - 2) + s]; h[4 * q4 + s] = (xv * rs) * pa[s] + pb[s]; } }
                u32x4 w; w.x = pk4_fp8(h[0], h[1], h[2], h[3]); w.y = pk4_fp8(h[4], h[5], h[6], h[7]); w.z = pk4_fp8(h[8], h[9], h[10], h[11]); w.w = pk4_fp8(h[12], h[13], h[14], h[15]);
                *(u32x4*)(hrow + 64 * c) = w;
#pragma unroll
                for (int g4 = 0; g4 < 4; ++g4) { const f32x4 bv = *(const LAS f32x4*)(rwB + (size_t)(((c * 4 + g4) * 64 + lane) << 2));
#pragma unroll
                    for (int s = 0; s < 4; ++s) acc = __builtin_amdgcn_mfma_f32_16x16x4f32(h[4 * g4 + s], bv[s], acc, 0, 0, 0); } } }
#pragma unroll
        for (int r = 0; r < 4; ++r) { float L[16];
#pragma unroll
            for (int e = 0; e < 16; ++e) L[e] = __shfl(acc[r], (lane & 48) + e);
            route_pick(a, L, m0 + 4 * kq + r, ti == 0, rbias, hist); }
    }
    __syncthreads(); if (threadIdx.x < 16) atomicAdd(WSP(unsigned, WS_CTL + CTL_CNT) + cnt_layer * 16 + threadIdx.x, hist[threadIdx.x]);
}

__device__ __forceinline__ void moe_tile_starts(const Args& a, LAS unsigned char* lds, int layer) {
    LAS int* ts = (LAS int*)(lds + MISC_TSTART);
    if (threadIdx.x == 0) { int acc = 0; const unsigned* cnt = WSP(unsigned, WS_CTL + CTL_CNT) + layer * 16;
        for (int e = 0; e < 16; ++e) { ts[e] = acc; acc += (int)((__hip_atomic_load(cnt + e, __ATOMIC_RELAXED, __HIP_MEMORY_SCOPE_AGENT) + 255u) >> 8); } ts[16] = acc; }
    __syncthreads();
}
__device__ __forceinline__ void moe_assign_phase(const Args& a, LAS unsigned char* lds, int wave, int lane, int layer) {
    LAS int* ts = (LAS int*)(lds + MISC_TSTART); LAS unsigned* hist = (LAS unsigned*)(lds + MISC_HIST); LAS unsigned* bbase = (LAS unsigned*)(lds + MISC_BBASE);
    moe_tile_starts(a, lds, layer);
    const int tid = threadIdx.x;
    for (int chunk = blockIdx.x; chunk < NTOK / 128; chunk += gridDim.x) {
        if (tid < 16) hist[tid] = 0u;
        __syncthreads();
        int e = 0, rank = 0; const int tok = chunk * 128 + (tid >> 1);
        if (tid < 256) { const int2 ee = WSP(int2, WS_TOKE)[tok]; e = (tid & 1) ? ee.y : ee.x; rank = (int)__hip_atomic_fetch_add(&hist[e], 1u, __ATOMIC_RELAXED, __HIP_MEMORY_SCOPE_WORKGROUP); }
        __syncthreads();
        if (tid < 16) bbase[tid] = atomicAdd(WSP(unsigned, WS_CTL + CTL_CUR) + layer * 16 + tid, hist[tid]);
        __syncthreads();
        if (tid < 256) { const int pos = ts[e] * 256 + (int)bbase[e] + rank; ((int*)WSP(int2, WS_TOKP))[tok * 2 + (tid & 1)] = pos; WSP(int, WS_ROWTOK)[pos] = tok; }
        __syncthreads();
    }
    { const unsigned* cnt = WSP(unsigned, WS_CTL + CTL_CNT) + layer * 16;
      for (int e = blockIdx.x; e < 16; e += gridDim.x) { const int c = (int)__hip_atomic_load(cnt + e, __ATOMIC_RELAXED, __HIP_MEMORY_SCOPE_AGENT), end = ((c + 255) >> 8) << 8;
          for (int r = c + tid; r < end; r += 512) WSP(int, WS_ROWTOK)[ts[e] * 256 + r] = 0; } }
}

template <bool GATHER_> struct MoeSchedT {
    static constexpr bool GATHER = GATHER_;
    int nM, nN, G, c; const LAS int* ts; const char* A; const char* B; size_t tA, tB, eB; const int* rowtab;
    __device__ __forceinline__ const char* gbase() const { return A; }
    __device__ __forceinline__ bool next(int i, g8::Unit& u) const { u.kind = 0; if (!g8::tile_of((long)i * G + c, nM, nN, u.pm, u.pn)) return false;
        int e = 0;
#pragma unroll
        for (int q = 1; q < 16; ++q) e += (u.pm >= ts[q]) ? 1 : 0;
        u.e = __builtin_amdgcn_readfirstlane(e); u.pm = __builtin_amdgcn_readfirstlane(u.pm); u.pn = __builtin_amdgcn_readfirstlane(u.pn); return true; }
    __device__ __forceinline__ const char* abase(const g8::Unit& u) const { return A + (size_t)u.pm * tA; }
    __device__ __forceinline__ const char* bbase(const g8::Unit& u) const { return B + (size_t)u.e * eB + (size_t)u.pn * tB; }
};
struct MultiSched {
    static constexpr bool GATHER = false;
    int G, c; const char* A; const char* ws;
    __device__ __forceinline__ bool next(int i, g8::Unit& u) const { const long L = (long)i * G + c; u.e = 0;
        if (L < 1024) { u.kind = 0; return g8::tile_of(L, 128, 8, u.pm, u.pn); }
        if (L < 1536) { u.kind = 1; return g8::tile_of(L - 1024, 128, 4, u.pm, u.pn); }
        u.kind = 2; return g8::tile_of(L - 1536, 128, 8, u.pm, u.pn); }
    __device__ __forceinline__ const char* abase(const g8::Unit& u) const { const int k1 = u.kind >= 1 ? 1 : 0, k2 = u.kind >= 2 ? 1 : 0; const int coff = 256 * k1 + k2 * (256 + 256 * (u.pn >> 1)); return A + ((size_t)u.pm * 256 * 1536 + coff) * 2; }
    __device__ __forceinline__ const char* bbase(const g8::Unit& u) const { const size_t k1 = u.kind >= 1 ? 1 : 0, k2 = u.kind >= 2 ? 1 : 0;
        return ws + WS_BWA + k1 * (WS_BG - WS_BWA) + k2 * (WS_BLRU - WS_BG) + (size_t)u.pn * 256 * 256 * 2; }
};
template <bool F8_> struct EpiBf16T {
    static constexpr bool PERM = true, F8 = F8_; static constexpr int SC_A = 0x7f7f7f7f, SC_B = 0x79797979; bf16_t* O; int ldc;
    __device__ __forceinline__ void operator()(const f32x4 (&acc)[2][2][4][2], const g8::Unit& u, int wr, int wc, int fr, int fq) const {
        const int row0 = u.pm * 256 + wr * 64 + fr, col0 = u.pn * 256 + wc * 32 + 8 * fq;
#pragma unroll
        for (int ai = 0; ai < 2; ++ai)
#pragma unroll
            for (int m = 0; m < 4; ++m) { bf16_t* rowp = O + (size_t)(row0 + ai * 128 + m * 16) * ldc + col0;
#pragma unroll
                for (int bj = 0; bj < 2; ++bj) { const f32x4 v0 = acc[ai][bj][m][0], v1 = acc[ai][bj][m][1];
                    u32x4 w; w.x = pk2(v0[0], v0[1]); w.y = pk2(v0[2], v0[3]); w.z = pk2(v1[0], v1[1]); w.w = pk2(v1[2], v1[3]); *(u32x4*)(rowp + bj * 128) = w; } }
    }
};
template <bool IN16> struct EpiResid {
    static constexpr bool PERM = true, F8 = true; static constexpr int SC_A = 0x7c7c7c7c, SC_B = 0x79797979; const void* xin; bf16_t* xout; const float* gate;
    __device__ __forceinline__ void operator()(const f32x4 (&acc)[2][2][4][2], const g8::Unit& u, int wr, int wc, int fr, int fq) const {
        const int row0 = u.pm * 256 + wr * 64 + fr, col0 = u.pn * 256 + wc * 32 + 8 * fq; const float* gp = gate + (size_t)(u.pm >> 5) * 12288 + col0;
        f32x4 gv[2][2];
#pragma unroll
        for (int bj = 0; bj < 2; ++bj)
#pragma unroll
            for (int n = 0; n < 2; ++n) gv[bj][n] = *(const f32x4*)(gp + bj * 128 + n * 4);
#pragma unroll
        for (int ai = 0; ai < 2; ++ai) { f32x4 xv[4][2][2];
#pragma unroll
            for (int m = 0; m < 4; ++m) { const size_t off = (size_t)(row0 + ai * 128 + m * 16) * DM + col0;
#pragma unroll
                for (int bj = 0; bj < 2; ++bj) {
                    if (IN16) { const u32x4 w = *(const u32x4*)((const bf16_t*)xin + off + bj * 128); xv[m][bj][0] = (f32x4){bflo(w.x), bfhi(w.x), bflo(w.y), bfhi(w.y)}; xv[m][bj][1] = (f32x4){bflo(w.z), bfhi(w.z), bflo(w.w), bfhi(w.w)}; }
                    else { xv[m][bj][0] = *(const f32x4*)((const float*)xin + off + bj * 128); xv[m][bj][1] = *(const f32x4*)((const float*)xin + off + bj * 128 + 4); } } }
            asm volatile("" ::: "memory");
#pragma unroll
            for (int m = 0; m < 4; ++m) { const size_t off = (size_t)(row0 + ai * 128 + m * 16) * DM + col0;
#pragma unroll
                for (int bj = 0; bj < 2; ++bj) { const f32x4 v0 = xv[m][bj][0] + gv[bj][0] * acc[ai][bj][m][0], v1 = xv[m][bj][1] + gv[bj][1] * acc[ai][bj][m][1];
                    u32x4 w; w.x = pk2(v0[0], v0[1]); w.y = pk2(v0[2], v0[3]); w.z = pk2(v1[0], v1[1]); w.w = pk2(v1[2], v1[3]); *(u32x4*)(xout + off + bj * 128) = w; } }
            asm volatile("" ::: "memory"); }
    }
};
struct EpiHid {
    static constexpr bool PERM = true, F8 = true; static constexpr int SC_A = 0x7f7f7f7f, SC_B = 0x79797979;
    unsigned char* O;
    __device__ __forceinline__ void operator()(const f32x4 (&acc)[2][2][4][2], const g8::Unit& u, int wr, int wc, int fr, int fq) const {
        const int row0 = u.pm * 256 + wr * 64 + fr, col0 = u.pn * 128 + wc * 32 + 8 * fq;
#pragma unroll
        for (int ai = 0; ai < 2; ++ai)
#pragma unroll
            for (int m = 0; m < 4; ++m) { float f[8];
#pragma unroll
                for (int n = 0; n < 2; ++n)
#pragma unroll
                    for (int i = 0; i < 4; ++i) f[n * 4 + i] = 4.0f * siluf_(acc[ai][0][m][n][i]) * acc[ai][1][m][n][i];
                u32x2 w; w.x = pk4_fp8(f[0], f[1], f[2], f[3]); w.y = pk4_fp8(f[4], f[5], f[6], f[7]);
                *(u32x2*)(O + (size_t)(row0 + ai * 128 + m * 16) * DEXP + col0) = w; }
    }
};
struct EpiY8 {
    static constexpr bool PERM = true, F8 = true; static constexpr int SC_A = 0x7f7f7f7f, SC_B = 0x7c7c7c7c; unsigned char* O; int ldc;
    __device__ __forceinline__ void operator()(const f32x4 (&acc)[2][2][4][2], const g8::Unit& u, int wr, int wc, int fr, int fq) const {
        const int row0 = u.pm * 256 + wr * 64 + fr, col0 = u.pn * 256 + wc * 32 + 8 * fq;
#pragma unroll
        for (int ai = 0; ai < 2; ++ai)
#pragma unroll
            for (int m = 0; m < 4; ++m) { unsigned char* rowp = O + (size_t)(row0 + ai * 128 + m * 16) * ldc + col0;
#pragma unroll
                for (int bj = 0; bj < 2; ++bj) { const f32x4 v0 = acc[ai][bj][m][0], v1 = acc[ai][bj][m][1];
                    u32x2 w; w.x = pk4_fp8(v0[0], v0[1], v0[2], v0[3]); w.y = pk4_fp8(v1[0], v1[1], v1[2], v1[3]); *(u32x2*)(rowp + bj * 128) = w; } }
    }
};
struct EpiL1 {
    static constexpr bool PERM = true, F8 = false; static constexpr int SC_A = 0, SC_B = 0;
    bf16_t *LD, *RKV, *KK, *BB, *GG, *LOGA, *UU; const bf16_t* LIN; const float *w0, *a0, *ka, *ba, *bx, *lam;
    __device__ __forceinline__ void operator()(const f32x4 (&acc)[2][2][4][2], const g8::Unit& u, int wr, int wc, int fr, int fq) const {
        const int row0 = u.pm * 256 + wr * 64 + fr;
        if (u.kind == 2) {
            const int ch0 = u.pn * 128 + wc * 32 + 8 * fq; float bav[8], bxv[8], spl[8];
#pragma unroll
            for (int i = 0; i < 8; ++i) { bav[i] = ba[ch0 + i]; bxv[i] = bx[ch0 + i]; spl[i] = -8.0f * softplusf_(-lam[ch0 + i]); }
#pragma unroll
            for (int ai = 0; ai < 2; ++ai) { u32x4 xr[4];
#pragma unroll
                for (int m = 0; m < 4; ++m) xr[m] = *(const u32x4*)(LIN + (size_t)(row0 + ai * 128 + m * 16) * 1536 + 512 + ch0);
                asm volatile("" ::: "memory");
#pragma unroll
                for (int m = 0; m < 4; ++m) { const size_t row = (size_t)(row0 + ai * 128 + m * 16); float xb[8], la[8], uu[8];
                    unpack8(xr[m], xb);
#pragma unroll
                    for (int n = 0; n < 2; ++n)
#pragma unroll
                        for (int i = 0; i < 4; ++i) { const int q = n * 4 + i; const float r = sigmoidf_(acc[ai][0][m][n][i] + bav[q]), ig = sigmoidf_(acc[ai][1][m][n][i] + bxv[q]);
                            const float l = spl[q] * r; la[q] = l; uu[q] = __builtin_sqrtf(fmaxf(1.0f - fast_exp(2.0f * l), 0.0f)) * (ig * xb[q]); }
                    *(u32x4*)(LOGA + row * 1024 + ch0) = pack8(la); *(u32x4*)(UU + row * 1024 + ch0) = pack8(uu); }
                asm volatile("" ::: "memory"); }
            return; }
#pragma unroll
        for (int bj = 0; bj < 2; ++bj) {
            const int colt = u.pn * 256 + bj * 128 + wc * 32 + 8 * fq;
            if (u.kind == 1) {
#pragma unroll
                for (int ai = 0; ai < 2; ++ai)
#pragma unroll
                    for (int m = 0; m < 4; ++m) { float f[8];
#pragma unroll
                        for (int q = 0; q < 8; ++q) f[q] = acc[ai][bj][m][q >> 2][q & 3];
                        *(u32x4*)(GG + (size_t)(row0 + ai * 128 + m * 16) * 1024 + colt) = pack8(f); asm volatile("" ::: "memory"); }
            } else if (colt < 1024) {
                float w0v[8];
#pragma unroll
                for (int q = 0; q < 8; ++q) w0v[q] = w0[colt + q];
#pragma unroll
                for (int ai = 0; ai < 2; ++ai)
#pragma unroll
                    for (int m = 0; m < 4; ++m) { float f[8];
#pragma unroll
                        for (int q = 0; q < 8; ++q) { const float w = -softplusf_(-(w0v[q] + acc[ai][bj][m][q >> 2][q & 3])) - 0.5f; f[q] = -fast_exp(w); }
                        *(u32x4*)(LD + (size_t)(row0 + ai * 128 + m * 16) * 1024 + colt) = pack8(f); asm volatile("" ::: "memory"); }
            } else {
                const int ch0 = colt - 1024; float a0v[8], kav[8];
#pragma unroll
                for (int q = 0; q < 8; ++q) { a0v[q] = a0[ch0 + q]; kav[q] = ka[ch0 + q]; }
#pragma unroll
                for (int ai = 0; ai < 2; ++ai) { u32x4 kr[4], kkr[4];
#pragma unroll
                    for (int m = 0; m < 4; ++m) { const size_t row = (size_t)(row0 + ai * 128 + m * 16); kr[m] = *(const u32x4*)(RKV + row * 3072 + 1024 + ch0); kkr[m] = *(const u32x4*)(KK + row * 1024 + ch0); }
                    asm volatile("" ::: "memory");
#pragma unroll
                    for (int m = 0; m < 4; ++m) { const size_t row = (size_t)(row0 + ai * 128 + m * 16); float kl[8], kkv[8], kp[8], bb[8];
                        unpack8(kr[m], kl); unpack8(kkr[m], kkv);
#pragma unroll
                        for (int q = 0; q < 8; ++q) { const float av = sigmoidf_(a0v[q] + acc[ai][bj][m][q >> 2][q & 3]); kp[q] = kl[q] * (1.0f + (av - 1.0f) * kav[q]); bb[q] = kkv[q] * av; }
                        *(u32x4*)(RKV + row * 3072 + 1024 + ch0) = pack8(kp); *(u32x4*)(BB + row * 1024 + ch0) = pack8(bb); }
                    asm volatile("" ::: "memory"); }
            }
        }
    }
};
constexpr int KS_PITCH = 72, VT_PITCH = 260;
__device__ __forceinline__ void attn_unit(const Args& a, LAS unsigned char* lds, int unit, int wave, int lane) {
    const bf16_t* Z = WSP(bf16_t, WS_Z); const f32x2* ROPE = WSP(f32x2, WS_ROPE); unsigned char* CAT = WSP(unsigned char, WS_CAT0);
    LAS bf16_t* Ks = (LAS bf16_t*)(lds + LDS_STAGE); LAS bf16_t* Vt = Ks + 256 * KS_PITCH;
    const int b = unit >> 8, nblk = (unit >> 2) & 63, kvh = unit & 3, tid = threadIdx.x;
    const int tok0 = b * SEQ + nblk * 128;
    const int head = kvh * 4 + (wave >> 1), l31 = lane & 31, h = lane >> 5;
    bf16x8 qfa[2][4];
#pragma unroll
    for (int rt = 0; rt < 2; ++rt) { const size_t tok = (size_t)(tok0 + ((wave & 1) * 2 + rt) * 32 + l31);
        float q[4][8]; const bf16_t* qp = Z + tok * AB_IN + head * 64 + 8 * h;
#pragma unroll
        for (int s = 0; s < 4; ++s) unpack8(*(const u32x4*)(qp + 16 * s), q[s]);
#pragma unroll
        for (int s = 0; s < 2; ++s) { const f32x4* cs = (const f32x4*)(ROPE + tok * 32 + 16 * s + 8 * h); float ol[8], oh[8];
#pragma unroll
            for (int j = 0; j < 4; ++j) { const f32x4 c2 = cs[j];
                ol[2 * j] = (q[s][2 * j] * c2.x - q[s + 2][2 * j] * c2.y) * 0.125f; oh[2 * j] = (q[s + 2][2 * j] * c2.x + q[s][2 * j] * c2.y) * 0.125f;
                ol[2 * j + 1] = (q[s][2 * j + 1] * c2.z - q[s + 2][2 * j + 1] * c2.w) * 0.125f; oh[2 * j + 1] = (q[s + 2][2 * j + 1] * c2.z + q[s][2 * j + 1] * c2.w) * 0.125f; }
            const u32x4 pl = pack8(ol), ph = pack8(oh); qfa[rt][s] = __builtin_bit_cast(bf16x8, pl); qfa[rt][s + 2] = __builtin_bit_cast(bf16x8, ph); } }
    __syncthreads();
#pragma unroll
    for (int i = 0; i < 2; ++i) { const int pp = tid + 512 * i, key = pp >> 2, d0 = (pp & 3) * 8; float lo[8], hi[8], ol[8], oh[8];
        if (nblk == 0 && key < 128) {
#pragma unroll
            for (int j = 0; j < 8; ++j) { ol[j] = 0.f; oh[j] = 0.f; }
        } else { const size_t row = (size_t)(tok0 - 128 + key); const bf16_t* kp = Z + row * AB_IN + 1024 + kvh * 64 + d0;
            unpack8(*(const u32x4*)kp, lo); unpack8(*(const u32x4*)(kp + 32), hi); const f32x4* cs = (const f32x4*)(ROPE + row * 32 + d0);
#pragma unroll
            for (int j = 0; j < 4; ++j) { const f32x4 c2 = cs[j];
                ol[2 * j] = lo[2 * j] * c2.x - hi[2 * j] * c2.y; oh[2 * j] = hi[2 * j] * c2.x + lo[2 * j] * c2.y;
                ol[2 * j + 1] = lo[2 * j + 1] * c2.z - hi[2 * j + 1] * c2.w; oh[2 * j + 1] = hi[2 * j + 1] * c2.z + lo[2 * j + 1] * c2.w; } }
        *(LAS u32x4*)(Ks + key * KS_PITCH + d0) = pack8(ol); *(LAS u32x4*)(Ks + key * KS_PITCH + d0 + 32) = pack8(oh); }
#pragma unroll
    for (int i = 0; i < 4; ++i) { const int p = tid + 512 * i, key = p >> 3, d0 = (p & 7) * 8; u32x4 w = {0u, 0u, 0u, 0u};
        if (!(nblk == 0 && key < 128)) w = *(const u32x4*)(Z + (size_t)(tok0 - 128 + key) * AB_IN + 1280 + kvh * 64 + d0);
        LAS bf16_t* vp = Vt + d0 * VT_PITCH + key;
        vp[0] = (bf16_t)(w.x & 0xffff); vp[VT_PITCH] = (bf16_t)(w.x >> 16); vp[2 * VT_PITCH] = (bf16_t)(w.y & 0xffff); vp[3 * VT_PITCH] = (bf16_t)(w.y >> 16);
        vp[4 * VT_PITCH] = (bf16_t)(w.z & 0xffff); vp[5 * VT_PITCH] = (bf16_t)(w.z >> 16); vp[6 * VT_PITCH] = (bf16_t)(w.w & 0xffff); vp[7 * VT_PITCH] = (bf16_t)(w.w >> 16); }
    __syncthreads();
    const float sink = FIN(I_SINKS)[head];
#pragma unroll
    for (int rt = 0; rt < 2; ++rt) {
        const int r = (wave & 1) * 2 + rt, qi = r * 32 + l31; const size_t tok = (size_t)(tok0 + qi);
        const bf16x8 (&qf)[4] = qfa[rt];
        f32x16 sc[5];
#pragma unroll
        for (int kt = 0; kt < 5; ++kt) {
#pragma unroll
            for (int i = 0; i < 16; ++i) sc[kt][i] = 0.f;
            const LAS bf16_t* kp = Ks + ((r + kt) * 32 + l31) * KS_PITCH + 8 * h;
#pragma unroll
            for (int s = 0; s < 4; ++s) { const bf16x8 kf = *(const LAS bf16x8*)(kp + 16 * s); sc[kt] = __builtin_amdgcn_mfma_f32_32x32x16_bf16(kf, qf[s], sc[kt], 0, 0, 0); } }
        float mx = -1e30f;
#pragma unroll
        for (int kt = 0; kt < 5; ++kt)
#pragma unroll
            for (int i = 0; i < 16; ++i) { const int kj = (r + kt) * 32 + (i & 3) + 8 * (i >> 2) + 4 * h; const bool valid = (kj > qi) && (kj <= qi + 128) && (nblk > 0 || kj >= 128);
                const float s = valid ? sc[kt][i] : -1e30f; sc[kt][i] = s; mx = fmaxf(mx, s); }
        mx = fmaxf(mx, __shfl_xor(mx, 32)); const float mfin = fmaxf(mx, sink); float lsum = 0.f;
#pragma unroll
        for (int kt = 0; kt < 5; ++kt)
#pragma unroll
            for (int i = 0; i < 16; ++i) { const float p = __builtin_amdgcn_exp2f((sc[kt][i] - mfin) * LOG2E); sc[kt][i] = p; lsum += p; }
        lsum += __shfl_xor(lsum, 32); const float inv = fast_rcp(lsum + __builtin_amdgcn_exp2f((sink - mfin) * LOG2E));
        f32x16 oa[2];
#pragma unroll
        for (int dt = 0; dt < 2; ++dt)
#pragma unroll
            for (int i = 0; i < 16; ++i) oa[dt][i] = 0.f;
#pragma unroll
        for (int kt = 0; kt < 5; ++kt)
#pragma unroll
            for (int s2 = 0; s2 < 2; ++s2) { u32x4 pw; pw.x = pk2(sc[kt][8 * s2], sc[kt][8 * s2 + 1]); pw.y = pk2(sc[kt][8 * s2 + 2], sc[kt][8 * s2 + 3]); pw.z = pk2(sc[kt][8 * s2 + 4], sc[kt][8 * s2 + 5]); pw.w = pk2(sc[kt][8 * s2 + 6], sc[kt][8 * s2 + 7]);
                const bf16x8 pf = __builtin_bit_cast(bf16x8, pw); const int kb = (r + kt) * 32 + 16 * s2 + 4 * h;
#pragma unroll
                for (int dt = 0; dt < 2; ++dt) { const LAS bf16_t* vp = Vt + (dt * 32 + l31) * VT_PITCH + kb; u32x4 vw; const u32x2 v0 = *(const LAS u32x2*)vp, v1 = *(const LAS u32x2*)(vp + 8);
                    vw.x = v0.x; vw.y = v0.y; vw.z = v1.x; vw.w = v1.y; oa[dt] = __builtin_amdgcn_mfma_f32_32x32x16_bf16(__builtin_bit_cast(bf16x8, vw), pf, oa[dt], 0, 0, 0); } }
        unsigned char* op = CAT + tok * DM + head * 64 + 4 * h; const float inv8 = inv * 8.0f;
#pragma unroll
        for (int dt = 0; dt < 2; ++dt)
#pragma unroll
            for (int g = 0; g < 4; ++g) *(unsigned*)(op + dt * 32 + 8 * g) = pk4_fp8(oa[dt][4 * g] * inv8, oa[dt][4 * g + 1] * inv8, oa[dt][4 * g + 2] * inv8, oa[dt][4 * g + 3] * inv8);
    }
}
__device__ __forceinline__ void conv_ld8(const bf16_t* Z, size_t rowb, int ch, int thi, int tfirst, int cntv, unsigned (&vv)[8], unsigned (&gg)[8]) {
#pragma unroll
    for (int i = 0; i < 8; ++i) if (i < cntv) { const int t = tfirst + i; vv[i] = 0u; gg[i] = 0u;
        if (t >= 0 && t < thi) { const char* zp = (const char*)(Z + (rowb + t) * AB_IN + 1536); const unsigned lo = (unsigned)ch * 2u; vv[i] = *(const unsigned*)(zp + lo); gg[i] = *(const unsigned*)(zp + 2048 + lo); } }
}
__device__ __forceinline__ void conv_unit(const Args& a, LAS unsigned char* lds, int unit, int wave, int lane) {
    const bf16_t* Z = WSP(bf16_t, WS_Z); bf16_t* TMP = WSP(bf16_t, WS_CONVTMP); unsigned char* CAT = WSP(unsigned char, WS_CAT0);
    const int tid = threadIdx.x, ch = 2 * tid, b = unit >> 6, t0 = (unit & 63) * 128; const size_t rowb = (size_t)b * SEQ;
    f32x2 w[31], win[31]; const float* cwp = FIN(I_CONVW);
#pragma unroll
    for (int j = 0; j < 31; ++j) { w[j] = *(const f32x2*)(cwp + j * 1024 + ch); win[j] = (f32x2){0.f, 0.f}; }
    unsigned va[8], ga[8], vb[8], gb[8];
    conv_ld8(Z, rowb, ch, t0 + 128, t0 - 31, 8, va, ga);
#define CONV_HALF(vv, gg, i0, cntv) do { _Pragma("unroll") for (int i = 0; i < 8; ++i) if (i < (cntv)) { const int ii = (i0) + i, t = bt + ii; const bool inb = (t >= 0 && t < t0 + 128); \
            f32x2 y; y.x = inb ? bflo(vv[i]) * sigmoidf_(bflo(gg[i])) : 0.f; y.y = inb ? bfhi(vv[i]) * sigmoidf_(bfhi(gg[i])) : 0.f; win[ii] = y; \
            if (t >= t0 && t < t0 + 128) { f32x2 oq[4]; _Pragma("unroll") for (int j = 0; j < 4; ++j) oq[j] = w[j] * win[(ii + 1 + j) % 31]; \
                _Pragma("unroll") for (int j = 4; j < 31; ++j) oq[j & 3] += w[j] * win[(ii + 1 + j) % 31]; const f32x2 o = (oq[0] + oq[1]) + (oq[2] + oq[3]); \
                *(unsigned*)((char*)(TMP + (rowb + t) * 1024) + (unsigned)ch * 2u) = pk2(o.x, o.y); asm volatile("" ::: "memory"); } } } while (0)
#pragma unroll 1
    for (int g = 0; g < 6; ++g) { const int bt = t0 - 31 + 31 * g;
        conv_ld8(Z, rowb, ch, t0 + 128, bt + 8, 8, vb, gb);  CONV_HALF(va, ga, 0, 8);
        conv_ld8(Z, rowb, ch, t0 + 128, bt + 16, 8, va, ga); CONV_HALF(vb, gb, 8, 8);
        conv_ld8(Z, rowb, ch, t0 + 128, bt + 24, 7, vb, gb); CONV_HALF(va, ga, 16, 8);
        conv_ld8(Z, rowb, ch, t0 + 128, bt + 31, 8, va, ga); CONV_HALF(vb, gb, 24, 7);
    }
#undef CONV_HALF
    asm volatile("s_waitcnt vmcnt(0)" ::: "memory"); __syncthreads();
    float lg[16], lb[16], cbv[16]; { const float* pg = FIN(I_CLNG) + 16 * lane; const float* pb = FIN(I_CLNB) + 16 * lane; const float* pc = FIN(I_CONVB) + 16 * lane;
#pragma unroll
        for (int q = 0; q < 4; ++q) { const f32x4 g4 = *(const f32x4*)(pg + 4 * q), b4 = *(const f32x4*)(pb + 4 * q), c4 = *(const f32x4*)(pc + 4 * q);
#pragma unroll
            for (int i = 0; i < 4; ++i) { lg[4 * q + i] = g4[i]; lb[4 * q + i] = b4[i]; cbv[4 * q + i] = c4[i]; } } }
#pragma unroll 1
    for (int i0 = 0; i0 < 16; i0 += 4) { u32x4 ra[4], rb[4];
#pragma unroll
        for (int u = 0; u < 4; ++u) { const u32x4* p = (const u32x4*)(TMP + (rowb + t0 + wave * 16 + i0 + u) * 1024 + 16 * lane); ra[u] = p[0]; rb[u] = p[1]; }
#pragma unroll
        for (int u = 0; u < 4; ++u) { float f0[8], f1[8]; unpack8(ra[u], f0); unpack8(rb[u], f1); float s = 0.f, q = 0.f;
#pragma unroll
            for (int i = 0; i < 8; ++i) { f0[i] += cbv[i]; f1[i] += cbv[8 + i]; s += f0[i] + f1[i]; q += f0[i] * f0[i] + f1[i] * f1[i]; }
            s = wave_sum(s); q = wave_sum(q);
            const float mean = s * (1.0f / 1024.0f), var = q * (1.0f / 1024.0f) - mean * mean, rstd = __builtin_amdgcn_rsqf(fmaxf(var, 0.f) + 1e-5f);
#pragma unroll
            for (int i = 0; i < 8; ++i) { f0[i] = siluf_((f0[i] - mean) * rstd * lg[i] + lb[i]); f1[i] = siluf_((f1[i] - mean) * rstd * lg[8 + i] + lb[8 + i]); }
            u32x4 w; w.x = pk4_fp8(8.0f * f0[0], 8.0f * f0[1], 8.0f * f0[2], 8.0f * f0[3]); w.y = pk4_fp8(8.0f * f0[4], 8.0f * f0[5], 8.0f * f0[6], 8.0f * f0[7]); w.z = pk4_fp8(8.0f * f1[0], 8.0f * f1[1], 8.0f * f1[2], 8.0f * f1[3]); w.w = pk4_fp8(8.0f * f1[4], 8.0f * f1[5], 8.0f * f1[6], 8.0f * f1[7]);
            *(u32x4*)(CAT + (rowb + t0 + wave * 16 + i0 + u) * DM + 1024 + 16 * lane) = w; } }
}

__device__ __forceinline__ void prep_phase(const Args& a, int wave, int lane) {
    const bf16_t* Z = WSP(bf16_t, WS_Z); bf16_t* RKV = WSP(bf16_t, WS_RKV); bf16_t* KK = WSP(bf16_t, WS_KK); bf16_t* LIN = WSP(bf16_t, WS_LIN);
    const int gw = blockIdx.x * 8 + wave, NGW = gridDim.x * 8;
    const float *pmu = FIN(I_MU), *pkk = FIN(I_KK), *plcb = FIN(I_LCB), *plcw = FIN(I_LCW);
    static_assert(PREP_PT == 4, "prep pass = 4 consecutive tokens");
    for (int mb = gw * 4; mb < NTOK; mb += 4 * NGW) { const int t0 = mb & (SEQ - 1); const bf16_t* zr0 = Z + (size_t)mb * ZLD1; const bool hasp = t0 > 0;
#pragma unroll
        for (int i = 0; i < 6; ++i) { const int col = (lane + 64 * i) * 8;
            const f32x4 m0 = *(const f32x4*)(pmu + col), m1 = *(const f32x4*)(pmu + col + 4); f32x4 k0 = m0, k1 = m1;
            if (i == 2 || i == 3) { k0 = *(const f32x4*)(pkk + col - 1024); k1 = *(const f32x4*)(pkk + col - 1024 + 4); }
            u32x4 R[5]; R[0] = (u32x4){0u, 0u, 0u, 0u}; if (hasp) R[0] = *(const u32x4*)(zr0 - ZLD1 + col);
#pragma unroll
            for (int tt = 0; tt < 4; ++tt) R[tt + 1] = *(const u32x4*)(zr0 + (size_t)tt * ZLD1 + col);
            float p[8]; unpack8(R[0], p);
#pragma unroll
            for (int tt = 0; tt < 4; ++tt) { const int m = mb + tt; float c[8], o[8]; unpack8(R[tt + 1], c);
#pragma unroll
                for (int j = 0; j < 8; ++j) { o[j] = c[j] + (j < 4 ? m0[j] : m1[j - 4]) * (p[j] - c[j]); p[j] = c[j]; }
                *(u32x4*)(RKV + (size_t)m * 3072 + col) = pack8(o);
                if (i == 2 || i == 3) { const int kc = col - 1024; float ss = 0.f;
#pragma unroll
                    for (int j = 0; j < 8; ++j) { o[j] *= (j < 4 ? k0[j] : k1[j - 4]); ss += o[j] * o[j]; }
                    ss += __shfl_xor(ss, 1); ss += __shfl_xor(ss, 2); ss += __shfl_xor(ss, 4); const float nrm = __builtin_amdgcn_rsqf(fmaxf(ss, 1e-24f));
#pragma unroll
                    for (int j = 0; j < 8; ++j) o[j] *= nrm;
                    *(u32x4*)(KK + (size_t)m * 1024 + kc) = pack8(o); } } }
        { const int col = 3072 + lane * 8; const bool pad = (col >= 3264 && col < 3328); const int mc = pad ? 3072 : (col >= 3328 ? col - 64 : col);
          const f32x4 m0 = *(const f32x4*)(pmu + mc), m1 = *(const f32x4*)(pmu + mc + 4);
          u32x4 R[5]; R[0] = (u32x4){0u, 0u, 0u, 0u}; if (hasp) R[0] = *(const u32x4*)(zr0 - ZLD1 + col);
#pragma unroll
          for (int tt = 0; tt < 4; ++tt) R[tt + 1] = *(const u32x4*)(zr0 + (size_t)tt * ZLD1 + col);
          float p[8]; unpack8(R[0], p);
#pragma unroll
          for (int tt = 0; tt < 4; ++tt) { const int m = mb + tt; float c[8], o[8]; unpack8(R[tt + 1], c);
#pragma unroll
              for (int j = 0; j < 8; ++j) { const float v = c[j] + (j < 4 ? m0[j] : m1[j - 4]) * (p[j] - c[j]); p[j] = c[j]; o[j] = pad ? 0.f : (col < 3168 ? tanhf_(v) : (col < 3264 ? v : sigmoidf_(v))); }
              *(u32x4*)(LIN + (size_t)m * 1536 + lane * 8) = pack8(o); } }
#pragma unroll
        for (int i = 0; i < 2; ++i) { const int ch = (lane + 64 * i) * 8; const f32x4 b0 = *(const f32x4*)(plcb + ch), b1 = *(const f32x4*)(plcb + ch + 4);
            f32x4 w0[4], w1[4];
#pragma unroll
            for (int q = 0; q < 4; ++q) { w0[q] = *(const f32x4*)(plcw + q * 1024 + ch); w1[q] = *(const f32x4*)(plcw + q * 1024 + ch + 4); }
            u32x4 X[7];
#pragma unroll
            for (int r = 0; r < 7; ++r) { X[r] = (u32x4){0u, 0u, 0u, 0u}; if (t0 - 3 + r >= 0) X[r] = *(const u32x4*)(zr0 + ((long)r - 3) * ZLD1 + 3584 + ch); }
            float xf[7][8];
#pragma unroll
            for (int r = 0; r < 7; ++r) unpack8(X[r], xf[r]);
#pragma unroll
            for (int tt = 0; tt < 4; ++tt) { const int m = mb + tt; float o[8];
#pragma unroll
                for (int j = 0; j < 8; ++j) o[j] = j < 4 ? b0[j] : b1[j - 4];
#pragma unroll
                for (int q = 0; q < 4; ++q)
#pragma unroll
                    for (int j = 0; j < 8; ++j) o[j] += (j < 4 ? w0[q][j] : w1[q][j - 4]) * xf[tt + q][j];
                *(u32x4*)(LIN + (size_t)m * 1536 + 512 + ch) = pack8(o); } }
    }
}

__device__ __forceinline__ float dpp_add(float x, float y_src, int) { return x + y_src; }
#define DPP_F(x, ctrl) __builtin_bit_cast(float, __builtin_amdgcn_update_dpp(0, __builtin_bit_cast(int, (x)), (ctrl), 0xf, 0xf, true))
__device__ __forceinline__ float row16_sum(float x) { x += DPP_F(x, 0xB1); x += DPP_F(x, 0x4E); x += DPP_F(x, 0x141); x += DPP_F(x, 0x140); return x; }
constexpr int SC_T = 16, SC_REC = 384, SC_NBUF = 5, SC_BUFB = SC_T * SC_REC * 4;
__device__ __forceinline__ void ldr_issue(const Args& a, u32x4 (&ld)[6], int chunk, int lw, int lane, size_t m0, int cb) {
    const bf16_t* RKV = WSP(bf16_t, WS_RKV); const bf16_t* LD = WSP(bf16_t, WS_LD); const bf16_t* KK = WSP(bf16_t, WS_KK); const bf16_t* BB = WSP(bf16_t, WS_BB);
#pragma unroll
    for (int j = 0; j < 6; ++j) { const int q = 6 * lw + j, arr = q >> 1, s = 8 * (q & 1) + (lane >> 3), part = lane & 7; const size_t m = m0 + (size_t)chunk * SC_T + s; const bf16_t* src;
        if (arr == 0) src = RKV + m * 3072 + cb; else if (arr == 1) src = LD + m * 1024 + cb; else if (arr == 2) src = RKV + m * 3072 + 1024 + cb;
        else if (arr == 3) src = KK + m * 1024 + cb; else if (arr == 4) src = BB + m * 1024 + cb; else src = RKV + m * 3072 + 2048 + cb;
        ld[j] = *(const u32x4*)(src + 8 * part); }
}
__device__ __forceinline__ void ldr_commit(LAS float* bp, const u32x4 (&ld)[6], int lw, int lane) {
#pragma unroll
    for (int j = 0; j < 6; ++j) { const int q = 6 * lw + j, arr = q >> 1, s = 8 * (q & 1) + (lane >> 3), part = lane & 7; float f[8]; unpack8(ld[j], f);
        if (arr == 1) {
#pragma unroll
            for (int i = 0; i < 8; ++i) f[i] = fast_exp(f[i]); }
        if (arr == 3) {
#pragma unroll
            for (int i = 0; i < 8; ++i) f[i] = -f[i]; }
        LAS float* dp = bp + s * SC_REC + arr * 64 + 8 * part;
        *(LAS f32x4*)dp = (f32x4){f[0], f[1], f[2], f[3]}; *(LAS f32x4*)(dp + 4) = (f32x4){f[4], f[5], f[6], f[7]}; }
}
__device__ __forceinline__ void scan_pair_of(int beta, int& b, int& hh, int& qd) { const int p = (beta & 7) + 8 * (beta >> 5); qd = (beta >> 3) & 3; b = p >> 4; hh = p & 15; }
__device__ __forceinline__ bool scan_all_done(LAS unsigned* done, int need) {
    bool ok = true;
#pragma unroll
    for (int w = 0; w < 4; ++w) ok = ok && ((int)__hip_atomic_load(done + w, __ATOMIC_RELAXED, __HIP_MEMORY_SCOPE_WORKGROUP) >= need);
    return ok;
}
__device__ __forceinline__ void scan_loader(const Args& a, LAS unsigned char* lds, int lw, int lane) {
    LAS float* buf = (LAS float*)(lds + LDS_STAGE); LAS unsigned* ready = (LAS unsigned*)(lds + MISC_SCAN) + 2 + lw; LAS unsigned* done = (LAS unsigned*)(lds + MISC_SCAN) + 4;
    int b, hh, qd; scan_pair_of(blockIdx.x, b, hh, qd); const int cb = hh * 64; const size_t m0 = (size_t)b * SEQ;
    constexpr int NCH = SEQ / SC_T;
    u32x4 A[6], B[6];
    ldr_issue(a, A, 0, lw, lane, m0, cb);
#pragma unroll 1
    for (int c = 0; c < NCH; c += 2) {
        ldr_issue(a, B, c + 1, lw, lane, m0, cb);
        while (!scan_all_done(done, c + 1 - SC_NBUF)) __builtin_amdgcn_s_sleep(2);
        asm volatile("" ::: "memory");
        ldr_commit(buf + (c % SC_NBUF) * (SC_T * SC_REC), A, lw, lane); lds_wait();
        if (lane == 0) __hip_atomic_fetch_add(ready, 1u, __ATOMIC_RELAXED, __HIP_MEMORY_SCOPE_WORKGROUP);
        if (c + 2 < NCH) ldr_issue(a, A, c + 2, lw, lane, m0, cb);
        while (!scan_all_done(done, c + 2 - SC_NBUF)) __builtin_amdgcn_s_sleep(2);
        asm volatile("" ::: "memory");
        ldr_commit(buf + ((c + 1) % SC_NBUF) * (SC_T * SC_REC), B, lw, lane); lds_wait();
        if (lane == 0) __hip_atomic_fetch_add(ready, 1u, __ATOMIC_RELAXED, __HIP_MEMORY_SCOPE_WORKGROUP);
    }
}
__device__ __forceinline__ float dot4(const f32x4 a, const f32x4 b) { return (a.x * b.x + a.y * b.y) + (a.z * b.z + a.w * b.w); }
struct ScanOps { f32x4 r, w, k, n, b; float v; };
template <int S> __device__ __forceinline__ void scan_ld(ScanOps& o, unsigned a128, unsigned a32) {
    asm volatile("ds_read_b128 %0, %6 offset:%8\n\tds_read_b128 %1, %6 offset:%9\n\tds_read_b128 %2, %6 offset:%10\n\tds_read_b128 %3, %6 offset:%11\n\tds_read_b128 %4, %6 offset:%12\n\tds_read_b32 %5, %7 offset:%13"
                 : "=&v"(o.r), "=&v"(o.w), "=&v"(o.k), "=&v"(o.n), "=&v"(o.b), "=&v"(o.v) : "v"(a128), "v"(a32),
                   "i"(S * SC_REC * 4), "i"(S * SC_REC * 4 + 256), "i"(S * SC_REC * 4 + 512), "i"(S * SC_REC * 4 + 768), "i"(S * SC_REC * 4 + 1024), "i"(S * SC_REC * 4 + 1280) : "memory");
}
#define SCAN_WAIT(o, cnt_) asm volatile("s_waitcnt lgkmcnt(" #cnt_ ")" : "+v"((o).r), "+v"((o).w), "+v"((o).k), "+v"((o).n), "+v"((o).b), "+v"((o).v) :: "memory")
__device__ __forceinline__ void rwkv_scan(const Args& a, LAS unsigned char* lds, int wave, int lane) {
    bf16_t* Y = WSP(bf16_t, WS_Y);
    LAS unsigned* ready = (LAS unsigned*)(lds + MISC_SCAN) + 2; LAS unsigned* done = (LAS unsigned*)(lds + MISC_SCAN) + 4 + wave;
    int b, hh, qd; scan_pair_of(blockIdx.x, b, hh, qd);
    const int kl = lane & 15, rl = lane >> 4;
    constexpr int NCH = SEQ / SC_T;
    bf16_t* yrow = Y + ((size_t)(b * 16 + hh) * SEQ) * 64 + 16 * qd + 4 * wave + rl;
    const unsigned a128b = (unsigned)LDS_STAGE + 16u * (unsigned)kl, a32b = (unsigned)LDS_STAGE + 4u * (unsigned)(16 * qd + 4 * wave + rl);
    f32x4 st = {0.f, 0.f, 0.f, 0.f}, rprev = {0.f, 0.f, 0.f, 0.f};
#define SCAN_STEP(o, s) do { float sa = fma_s(st.y, (o).n.y, mul_s(st.x, (o).n.x)) + fma_s(st.w, (o).n.w, mul_s(st.z, (o).n.z)), yy = dot4(st, rprev); \
        sa += DPP_F(sa, 0xB1); yy += DPP_F(yy, 0xB1); sa += DPP_F(sa, 0x4E); yy += DPP_F(yy, 0x4E); sa += DPP_F(sa, 0x141); yy += DPP_F(yy, 0x141); sa += DPP_F(sa, 0x140); yy += DPP_F(yy, 0x140); \
        ykeep = (kl == (s)) ? yy : ykeep; st = (o).b * sa + (st * (o).w + (o).k * (o).v); rprev = (o).r; } while (0)
#define SCAN_CHUNK(c, oa, ob, oc) do { \
        if (lane == 0 && (c) > 0) __hip_atomic_fetch_add(done, 1u, __ATOMIC_RELAXED, __HIP_MEMORY_SCOPE_WORKGROUP); \
        if ((c) + 1 < NCH) { while (__hip_atomic_load(ready, __ATOMIC_RELAXED, __HIP_MEMORY_SCOPE_WORKGROUP) < (unsigned)((c) + 2) || __hip_atomic_load(ready + 1, __ATOMIC_RELAXED, __HIP_MEMORY_SCOPE_WORKGROUP) < (unsigned)((c) + 2)) __builtin_amdgcn_s_sleep(1); } \
        asm volatile("s_waitcnt lgkmcnt(0)" ::: "memory"); \
        const unsigned cur_ = (unsigned)(((c) % SC_NBUF) * SC_BUFB), nxt_ = (unsigned)((((c) + 1) % SC_NBUF) * SC_BUFB); \
        const unsigned a128 = a128b + cur_, a32 = a32b + cur_, n128 = a128b + nxt_, n32 = a32b + nxt_; float ykeep = 0.f; \
        scan_ld<2>(oc, a128, a32); SCAN_WAIT(oa, 12); SCAN_STEP(oa, 0);   scan_ld<3>(oa, a128, a32); SCAN_WAIT(ob, 12); SCAN_STEP(ob, 1);   scan_ld<4>(ob, a128, a32); SCAN_WAIT(oc, 12); SCAN_STEP(oc, 2); \
        scan_ld<5>(oc, a128, a32); SCAN_WAIT(oa, 12); SCAN_STEP(oa, 3);   scan_ld<6>(oa, a128, a32); SCAN_WAIT(ob, 12); SCAN_STEP(ob, 4);   scan_ld<7>(ob, a128, a32); SCAN_WAIT(oc, 12); SCAN_STEP(oc, 5); \
        scan_ld<8>(oc, a128, a32); SCAN_WAIT(oa, 12); SCAN_STEP(oa, 6);   scan_ld<9>(oa, a128, a32); SCAN_WAIT(ob, 12); SCAN_STEP(ob, 7);   scan_ld<10>(ob, a128, a32); SCAN_WAIT(oc, 12); SCAN_STEP(oc, 8); \
        scan_ld<11>(oc, a128, a32); SCAN_WAIT(oa, 12); SCAN_STEP(oa, 9);  scan_ld<12>(oa, a128, a32); SCAN_WAIT(ob, 12); SCAN_STEP(ob, 10); scan_ld<13>(ob, a128, a32); SCAN_WAIT(oc, 12); SCAN_STEP(oc, 11); \
        scan_ld<14>(oc, a128, a32); SCAN_WAIT(oa, 12); SCAN_STEP(oa, 12); scan_ld<15>(oa, a128, a32); SCAN_WAIT(ob, 12); SCAN_STEP(ob, 13); \
        if ((c) + 1 < NCH) { scan_ld<0>(ob, n128, n32); SCAN_WAIT(oc, 12); SCAN_STEP(oc, 14); scan_ld<1>(oc, n128, n32); SCAN_WAIT(oa, 12); SCAN_STEP(oa, 15); } \
        else { SCAN_WAIT(oc, 6); SCAN_STEP(oc, 14); SCAN_WAIT(oa, 0); SCAN_STEP(oa, 15); } \
        { const int t = (c) * SC_T + kl - 1; if (t >= 0) yrow[(size_t)t * 64] = (bf16_t)(pk2(ykeep, 0.f) & 0xffff); } \
    } while (0)
    ScanOps o0, o1, o2;
    while (__hip_atomic_load(ready, __ATOMIC_RELAXED, __HIP_MEMORY_SCOPE_WORKGROUP) < 1u || __hip_atomic_load(ready + 1, __ATOMIC_RELAXED, __HIP_MEMORY_SCOPE_WORKGROUP) < 1u) __builtin_amdgcn_s_sleep(1);
    asm volatile("s_waitcnt lgkmcnt(0)" ::: "memory");
    scan_ld<0>(o0, a128b, a32b); scan_ld<1>(o1, a128b, a32b);
#pragma unroll 1
    for (int c = 0; c + 2 < NCH; c += 3) { SCAN_CHUNK(c, o0, o1, o2); SCAN_CHUNK(c + 1, o1, o2, o0); SCAN_CHUNK(c + 2, o2, o0, o1); }
    SCAN_CHUNK(NCH - 2, o0, o1, o2); SCAN_CHUNK(NCH - 1, o1, o2, o0);
#undef SCAN_CHUNK
#undef SCAN_STEP
    if (lane == 0) __hip_atomic_fetch_add(done, 1u, __ATOMIC_RELAXED, __HIP_MEMORY_SCOPE_WORKGROUP);
    { float yy = dot4(st, rprev); yy += DPP_F(yy, 0xB1); yy += DPP_F(yy, 0x4E); yy += DPP_F(yy, 0x141); yy += DPP_F(yy, 0x140);
      if (kl == 0) yrow[(size_t)(SEQ - 1) * 64] = (bf16_t)(pk2(yy, 0.f) & 0xffff); }
}
__device__ __forceinline__ void lru_local(const Args& a, int item, int lane) {
    const int b = item >> 9, c = (item >> 3) & 63, ch = (item & 7) * 128 + lane * 2; const size_t m0 = (size_t)b * SEQ + (size_t)c * 128;
    const bf16_t* LOGA = WSP(bf16_t, WS_LOGA) + m0 * 1024 + ch; const bf16_t* UU = WSP(bf16_t, WS_U) + m0 * 1024 + ch;
    float h0 = 0.f, h1 = 0.f, l0 = 0.f, l1 = 0.f;
#pragma unroll 1
    for (int t0 = 0; t0 < 128; t0 += 16) { unsigned la[16], uv[16];
#pragma unroll
        for (int i = 0; i < 16; ++i) { la[i] = *(const unsigned*)(LOGA + (size_t)(t0 + i) * 1024); uv[i] = *(const unsigned*)(UU + (size_t)(t0 + i) * 1024); }
#pragma unroll
        for (int i = 0; i < 16; ++i) { const float x0 = bflo(la[i]), x1 = bfhi(la[i]); h0 = fast_exp(x0) * h0 + bflo(uv[i]); h1 = fast_exp(x1) * h1 + bfhi(uv[i]); l0 += x0; l1 += x1; } }
    const size_t so = ((size_t)(b * 64 + c)) * 1024 + ch;
    *(f32x2*)(WSP(float, WS_SUMA) + so) = (f32x2){fast_exp(l0), fast_exp(l1)}; *(f32x2*)(WSP(float, WS_SUMH) + so) = (f32x2){h0, h1};
}
__device__ __forceinline__ void scan_phase(const Args& a, LAS unsigned char* lds, int wave, int lane) {
    if (threadIdx.x == 0) { LAS unsigned* cw = (LAS unsigned*)(lds + MISC_SCAN); for (int i = 0; i < 8; ++i) cw[i] = 0u; }
    __syncthreads();
    if (wave < 4) { if ((int)blockIdx.x < 256) rwkv_scan(a, lds, wave, lane); }
    else if (wave >= 6) { if ((int)blockIdx.x < 256) scan_loader(a, lds, wave - 6, lane); }
    else { const int sw = blockIdx.x * 2 + (wave - 4), NSW = gridDim.x * 2;
        for (int it = sw; it < 2048; it += NSW) lru_local(a, it, lane);
        LAS float* scr = (LAS float*)(lds + LDS_STAGE + SC_NBUF * SC_BUFB + (wave - 4) * 16640);
        moe_convert_range<1>(a, 1, sw, NSW, scr, lane); }
}

__device__ __forceinline__ void post_phase(const Args& a, int wave, int lane) {
    const bf16_t* RKV = WSP(bf16_t, WS_RKV); const bf16_t* Y = WSP(bf16_t, WS_Y); const bf16_t* GG = WSP(bf16_t, WS_G); const bf16_t* Z = WSP(bf16_t, WS_Z); unsigned char* CAT = WSP(unsigned char, WS_CAT1);
    const int gw = blockIdx.x * 8 + wave, NGW = gridDim.x * 8;
    for (int item = gw; item < 2048; item += NGW) { const int b = item >> 9, c = (item >> 3) & 63, ch = (item & 7) * 128 + lane * 2; const size_t m0 = (size_t)b * SEQ + (size_t)c * 128;
        float h0 = 0.f, h1 = 0.f;
        for (int c0 = 0; c0 < c; c0 += 8) { f32x2 A[8], H[8];
#pragma unroll
            for (int u = 0; u < 8; ++u) { const int cc = (c0 + u < c) ? c0 + u : c - 1; const size_t so = ((size_t)(b * 64 + cc)) * 1024 + ch; A[u] = *(const f32x2*)(WSP(float, WS_SUMA) + so); H[u] = *(const f32x2*)(WSP(float, WS_SUMH) + so); }
#pragma unroll
            for (int u = 0; u < 8; ++u) if (c0 + u < c) { h0 = A[u].x * h0 + H[u].x; h1 = A[u].y * h1 + H[u].y; } }
        const bf16_t* LOGA = WSP(bf16_t, WS_LOGA) + m0 * 1024 + ch; const bf16_t* UU = WSP(bf16_t, WS_U) + m0 * 1024 + ch; const bf16_t* GB = Z + m0 * ZLD1 + 4608 + ch; unsigned char* O = CAT + m0 * DM + 1024 + ch;
#pragma unroll 1
        for (int t0 = 0; t0 < 128; t0 += 16) { unsigned la[16], uv[16], gb[16];
#pragma unroll
            for (int i = 0; i < 16; ++i) { la[i] = *(const unsigned*)(LOGA + (size_t)(t0 + i) * 1024); uv[i] = *(const unsigned*)(UU + (size_t)(t0 + i) * 1024); gb[i] = *(const unsigned*)(GB + (size_t)(t0 + i) * ZLD1); }
#pragma unroll
            for (int i = 0; i < 16; ++i) { h0 = fast_exp(bflo(la[i])) * h0 + bflo(uv[i]); h1 = fast_exp(bfhi(la[i])) * h1 + bfhi(uv[i]);
                *(unsigned short*)(O + (size_t)(t0 + i) * DM) = (unsigned short)(pk4_fp8(8.0f * h0 * gelu_tanh(bflo(gb[i])), 8.0f * h1 * gelu_tanh(bfhi(gb[i])), 0.f, 0.f) & 0xffffu); } } }
    const int hd = lane >> 2, seg = (lane & 3) * 16, ch = hd * 64 + seg;
    float lg0[8], lg1[8], lb0[8], lb1[8], rk0[8], rk1[8]; const float *plg = FIN(I_LNXG), *plb = FIN(I_LNXB), *prk = FIN(I_RK);
#pragma unroll
    for (int j = 0; j < 8; ++j) { lg0[j] = plg[ch + j]; lg1[j] = plg[ch + 8 + j]; lb0[j] = plb[ch + j]; lb1[j] = plb[ch + 8 + j]; rk0[j] = prk[ch + j]; rk1[j] = prk[ch + 8 + j]; }
    for (int m = gw; m < NTOK; m += NGW) { const int b = m >> 13, t = m & (SEQ - 1);
        float y0[8], y1[8], r0[8], r1[8], k0[8], k1[8], v0[8], v1[8], g0[8], g1[8];
        { const u32x4* p = (const u32x4*)(Y + (((size_t)(b * 16 + hd) * SEQ) + t) * 64 + seg); unpack8(p[0], y0); unpack8(p[1], y1); }
        { const u32x4* p = (const u32x4*)(RKV + (size_t)m * 3072 + ch); unpack8(p[0], r0); unpack8(p[1], r1); }
        { const u32x4* p = (const u32x4*)(RKV + (size_t)m * 3072 + 1024 + ch); unpack8(p[0], k0); unpack8(p[1], k1); }
        { const u32x4* p = (const u32x4*)(RKV + (size_t)m * 3072 + 2048 + ch); unpack8(p[0], v0); unpack8(p[1], v1); }
        { const u32x4* p = (const u32x4*)(GG + (size_t)m * 1024 + ch); unpack8(p[0], g0); unpack8(p[1], g1); }
        float s = 0.f, dot = 0.f;
#pragma unroll
        for (int j = 0; j < 8; ++j) { s += y0[j] + y1[j]; dot += r0[j] * k0[j] * rk0[j] + r1[j] * k1[j] * rk1[j]; }
        s += __shfl_xor(s, 1); s += __shfl_xor(s, 2); dot += __shfl_xor(dot, 1); dot += __shfl_xor(dot, 2);
        const float mu = s * (1.0f / 64.0f); float q = 0.f;
#pragma unroll
        for (int j = 0; j < 8; ++j) { const float d0 = y0[j] - mu, d1 = y1[j] - mu; q += d0 * d0 + d1 * d1; }
        q += __shfl_xor(q, 1); q += __shfl_xor(q, 2); const float rstd = __builtin_amdgcn_rsqf(q * (1.0f / 64.0f) + 64e-5f);
        float o0[8], o1[8];
#pragma unroll
        for (int j = 0; j < 8; ++j) { o0[j] = 8.0f * ((y0[j] - mu) * rstd * lg0[j] + lb0[j] + dot * v0[j]) * g0[j]; o1[j] = 8.0f * ((y1[j] - mu) * rstd * lg1[j] + lb1[j] + dot * v1[j]) * g1[j]; }
        u32x4 w; w.x = pk4_fp8(o0[0], o0[1], o0[2], o0[3]); w.y = pk4_fp8(o0[4], o0[5], o0[6], o0[7]); w.z = pk4_fp8(o1[0], o1[1], o1[2], o1[3]); w.w = pk4_fp8(o1[4], o1[5], o1[6], o1[7]);
        *(u32x4*)(CAT + (size_t)m * DM + ch) = w;
    }
}
#ifndef MK_PER_PHASE
#define MK_PER_PHASE 0
#endif
constexpr int N_PHASES = 21;
__global__ void __launch_bounds__(512, 2) fwd(Args a) {
    extern __shared__ __attribute__((aligned(16))) unsigned char lds_raw[];
    LAS unsigned char* lds = (LAS unsigned char*)lds_raw;
    const int tid = threadIdx.x, wave = __builtin_amdgcn_readfirstlane(tid >> 6);
#define lane (lane_now())
    if (tid < 64) ((LAS unsigned*)lds)[tid] = 0u;
    __syncthreads();
    unsigned* barw = WSP(unsigned, WS_CTL) + a.li * XCD_BAR_WORDS;
    XcdBarrier bar; bar.bar = barw; bar.x = 0; bar.st = nullptr;
    if (!MK_PER_PHASE) bar = xcd_barrier_post(barw, (volatile LAS unsigned*)(lds + MISC_XB));
    const int lo = a.ph_lo, hi = a.ph_hi;
#ifndef PHMASK
#define PHMASK 0x1fffff
#endif
#define IN(k) (((PHMASK >> (k)) & 1) && lo <= (k) && (k) < hi)
#ifndef REPMASK
#define REPMASK 0
#endif
#define NREP(k) (((REPMASK >> (k)) & 1) ? 2 : 1)
#define SEAM(k) do { if ((k) + 1 < hi) { if (!MK_PER_PHASE) xcd_barrier(bar); } } while (0)
    const int G = gridDim.x, c = blockIdx.x;
    float* MOD = WSP(float, WS_CTL + CTL_MOD);
    LAS unsigned char* stage = lds + LDS_STAGE;

    if (IN(0)) {  p0_prologue(a, lds, wave, lane);  SEAM(0); }
    if (IN(1)) {  norm_phase<0, false, true>(a, wave, lane, FIN(I_X), FIN(I_NMIX), MOD, 0, nullptr);  SEAM(1); }
    if (IN(2)) {  g8::DenseSched S{NTOK / 256, AB_IN / 256, G, c, (const char*)WSP(unsigned char, WS_H), (const char*)WSP(unsigned char, WS_WIN0), (size_t)256 * DM, (size_t)256 * DM};
        EpiBf16T<true> E{WSP(bf16_t, WS_Z), AB_IN}; g8::gemm_phase(stage, DM / 2, DM / 2, DM / 2, S, E);
        SEAM(2);
        }
    if (IN(3)) {  for (int u = c; u < 1024; u += G) attn_unit(a, lds, u, wave, lane);
        for (int u = c; u < 256; u += G) conv_unit(a, lds, u, wave, lane);  SEAM(3); }
    if (IN(4)) {  g8::DenseSched S{NTOK / 256, DM / 256, G, c, (const char*)WSP(unsigned char, WS_CAT0), (const char*)WSP(unsigned char, WS_WOUT0), (size_t)256 * DM, (size_t)256 * DM};
        EpiResid<false> E{FIN(I_X), (bf16_t*)a.out, MOD + 2 * DM}; g8::gemm_phase(stage, DM / 2, DM / 2, DM / 2, S, E);  SEAM(4); }
    if (IN(5)) { route_norm_phase(a, lds, wave, lane, (const bf16_t*)a.out, FIN(I_NFFN), MOD, 3, 0); SEAM(5); }
    if (IN(6)) { moe_assign_phase(a, lds, wave, lane, 0); SEAM(6); }
    if (IN(7)) {  moe_tile_starts(a, lds, 0); const LAS int* ts = (const LAS int*)(lds + MISC_TSTART);
        MoeSchedT<true> S{__builtin_amdgcn_readfirstlane(ts[16]), 8, G, c, ts, (const char*)WSP(unsigned char, WS_H), (const char*)WSP(unsigned char, WS_MW13), (size_t)256 * DM, (size_t)256 * DM, (size_t)2048 * 2048, WSP(int, WS_ROWTOK)};
        EpiHid E{WSP(unsigned char, WS_HID)}; g8::gemm_phase(stage, DM / 2, DM / 2, DM / 2, S, E);  SEAM(7); }
    if (IN(8)) {  moe_tile_starts(a, lds, 0); const LAS int* ts = (const LAS int*)(lds + MISC_TSTART);
        MoeSchedT<false> S{__builtin_amdgcn_readfirstlane(ts[16]), 8, G, c, ts, (const char*)WSP(unsigned char, WS_HID), (const char*)WSP(unsigned char, WS_MW2), (size_t)256 * DEXP, (size_t)256 * DEXP, (size_t)2048 * 1024, nullptr};
        EpiY8 E{WSP(unsigned char, WS_YB), DM}; g8::gemm_phase(stage, DEXP / 2, DEXP / 2, DEXP / 2, S, E);  SEAM(8); }
    if (IN(9)) { norm_phase<1, true, true>(a, wave, lane, a.out, FIN(I_NMIX) + DM, MOD + 4 * 12288, 0, MOD + 5 * DM); SEAM(9); }
    if (IN(10)) {  g8::DenseSched S{NTOK / 256, ZLD1 / 256, G, c, (const char*)WSP(unsigned char, WS_H), (const char*)WSP(unsigned char, WS_WIN1), (size_t)256 * DM, (size_t)256 * DM};
        EpiBf16T<true> E{WSP(bf16_t, WS_Z), ZLD1}; g8::gemm_phase(stage, DM / 2, DM / 2, DM / 2, S, E);  SEAM(10); }
    if (IN(11)) {  prep_phase(a, wave, lane);  SEAM(11); }
    if (IN(12)) { MultiSched S{G, c, (const char*)WSP(bf16_t, WS_LIN), (const char*)a.ws};
        EpiL1 E{WSP(bf16_t, WS_LD), WSP(bf16_t, WS_RKV), WSP(bf16_t, WS_KK), WSP(bf16_t, WS_BB), WSP(bf16_t, WS_G), WSP(bf16_t, WS_LOGA), WSP(bf16_t, WS_U), WSP(bf16_t, WS_LIN),
                FIN(I_W0), FIN(I_A0), FIN(I_KA), FIN(I_LBA), FIN(I_LBX), FIN(I_LAM)};
        g8::gemm_phase(stage, 1536, 256, 256, S, E); SEAM(12); }
    if (IN(13)) {  scan_phase(a, lds, wave, lane);  SEAM(13); }
    if (IN(14)) {  post_phase(a, wave, lane);  SEAM(14); }
    if (IN(15)) { g8::DenseSched S{NTOK / 256, DM / 256, G, c, (const char*)WSP(unsigned char, WS_CAT1), (const char*)WSP(unsigned char, WS_WOUT1), (size_t)256 * DM, (size_t)256 * DM};
        EpiResid<true> E{a.out, WSP(bf16_t, WS_X3), MOD + 4 * 12288 + 2 * DM}; g8::gemm_phase(stage, DM / 2, DM / 2, DM / 2, S, E); SEAM(15); }
    if (IN(16)) { route_norm_phase(a, lds, wave, lane, WSP(bf16_t, WS_X3), FIN(I_NFFN) + DM, MOD + 4 * 12288, 3, 1); SEAM(16); }
    if (IN(17)) { moe_assign_phase(a, lds, wave, lane, 1); SEAM(17); }
    if (IN(18)) {  moe_tile_starts(a, lds, 1); const LAS int* ts = (const LAS int*)(lds + MISC_TSTART);
        MoeSchedT<true> S{__builtin_amdgcn_readfirstlane(ts[16]), 8, G, c, ts, (const char*)WSP(unsigned char, WS_H), (const char*)WSP(unsigned char, WS_MW13), (size_t)256 * DM, (size_t)256 * DM, (size_t)2048 * 2048, WSP(int, WS_ROWTOK)};
        EpiHid E{WSP(unsigned char, WS_HID)}; g8::gemm_phase(stage, DM / 2, DM / 2, DM / 2, S, E);  SEAM(18); }
    if (IN(19)) {  moe_tile_starts(a, lds, 1); const LAS int* ts = (const LAS int*)(lds + MISC_TSTART);
        MoeSchedT<false> S{__builtin_amdgcn_readfirstlane(ts[16]), 8, G, c, ts, (const char*)WSP(unsigned char, WS_HID), (const char*)WSP(unsigned char, WS_MW2), (size_t)256 * DEXP, (size_t)256 * DEXP, (size_t)2048 * 1024, nullptr};
        EpiY8 E{WSP(unsigned char, WS_YB), DM}; g8::gemm_phase(stage, DEXP / 2, DEXP / 2, DEXP / 2, S, E);  SEAM(19); }
    if (IN(20)) { norm_phase<5, true>(a, wave, lane, WSP(bf16_t, WS_X3), FIN(I_FNORM), MOD, 0, MOD + 4 * 12288 + 5 * DM); }
#undef IN
#undef SEAM
#undef lane
}

extern "C" void kernel_launch(void* const* d_in, const int* in_sizes, int n_in, void* d_out, int out_size, void* d_ws, size_t ws_size, hipStream_t stream) {
    static int grid = 0;
    if (grid == 0) {
        if (n_in != 40 || in_sizes[0] != NTOK * DM || out_size != NTOK * DM || ws_size < WS_END) { fprintf(stderr, "kernel_launch: unexpected shapes (n_in %d, ws %zu < %zu)\n", n_in, ws_size, (size_t)WS_END); grid = -1; return; }
        int dev = 0, cus = 0, per_cu = 0;
        if (hipGetDevice(&dev) != hipSuccess || hipDeviceGetAttribute(&cus, hipDeviceAttributeMultiprocessorCount, dev) != hipSuccess) { grid = -1; return; }
        if (hipFuncSetAttribute((const void*)fwd, hipFuncAttributeMaxDynamicSharedMemorySize, LDS_BYTES) != hipSuccess) { fprintf(stderr, "kernel_launch: hipFuncSetAttribute failed\n"); grid = -1; return; }
        if (hipOccupancyMaxActiveBlocksPerMultiprocessor(&per_cu, (const void*)fwd, 512, LDS_BYTES) != hipSuccess || per_cu < 1) fprintf(stderr, "kernel_launch: occupancy query reports %d\n", per_cu);
        (void)hipGetLastError();
        grid = cus;
        if (grid != 256) fprintf(stderr, "kernel_launch: %d CUs (built for 256)\n", grid);
    }
    if (grid < 0) return;
    (void)hipMemsetAsync((char*)d_ws + WS_CTL, 0, CTL_ZERO_BYTES, stream);
    Args a{};
    for (int i = 0; i < 40; ++i) a.in[i] = d_in[i];
    a.out = (float*)d_out; a.ws = (unsigned char*)d_ws;
#if MK_PER_PHASE
    for (int k = 0; k < N_PHASES; ++k) { a.ph_lo = k; a.ph_hi = k + 1; hipLaunchKernelGGL(fwd, dim3(grid), dim3(512), LDS_BYTES, stream, a); }
#else
#ifdef PROBE_K
    a.ph_lo = 0; a.ph_hi = PROBE_K; a.li = 1; hipLaunchKernelGGL(fwd, dim3(grid), dim3(512), LDS_BYTES, stream, a);
#endif
    a.ph_lo = 0; a.ph_hi = N_PHASES; a.li = 0; hipLaunchKernelGGL(fwd, dim3(grid), dim3(512), LDS_BYTES, stream, a);
#endif
}
```
